# Optimizing an MI355X kernel written in HIP

```python
import math
import jax, jax.numpy as jnp
from jax import lax
import numpy as np

D_MODEL = 1024
BATCH = 4
SEQ = 8192
DEPTH = 4

HY_WIDTH = 512
HY_ORDER = 2
HY_EMB = 33
HY_FILT_HIDDEN = 64
HY_FAST_DECAY = 0.3
HY_SLOW_DECAY = 1.5
HY_DECAY_TARGET = 1e-2
RET_HEADS = 4
RET_DK = 64
RET_DV = 128
RET_QK = RET_HEADS * RET_DK
RET_V = RET_HEADS * RET_DV
RET_CHUNK = 128
RET_DECAY_FWD = 5.0
RET_DECAY_BWD = 5.5
ROPE_BASE = 10000.0
N_BRANCH = 2
IN_COLS = 3 * HY_WIDTH + 2 * RET_QK + 2 * RET_V + N_BRANCH * D_MODEL
N_EXPERTS = 32
TOP_K = 4
D_FF = D_MODEL
SWIGLU_ALPHA = 1.702
SWIGLU_LIMIT = 7.0
MOE_BLOCK = 256
N_MOD = 6
EPS = 1e-6

kernel_name = "hyena_retention_moe_adaln_encoder"


def rms_norm(x, g):
    xf = x.astype(jnp.float32)
    y = xf * lax.rsqrt(jnp.mean(xf * xf, axis=-1, keepdims=True) + EPS)
    return (y * g.astype(jnp.float32)).astype(x.dtype)


def hyena_pos_features(L):
    f32 = jnp.float32
    t = jnp.linspace(0.0, 1.0, L, dtype=f32)[:, None]
    bands = (HY_EMB - 1) // 2
    w = 2.0 * jnp.pi * jnp.arange(L, dtype=f32)[:, None] / L
    f = jnp.linspace(1e-4, bands - 1, bands, dtype=f32)[None, :]
    feats = jnp.concatenate([t, jnp.cos(f * w), -jnp.sin(f * w)], axis=-1)
    return feats, t[:, 0]


def hyena_filters(pos_feat, t_norm, w1, b1, w2, b2, w3, b3, w4, freq):
    f32 = jnp.float32
    L = pos_feat.shape[0]
    fr = freq.astype(f32)
    h = jnp.sin(fr * (pos_feat @ w1.astype(f32) + b1.astype(f32)))
    h = jnp.sin(fr * (h @ w2.astype(f32) + b2.astype(f32)))
    h = jnp.sin(fr * (h @ w3.astype(f32) + b3.astype(f32)))
    h = (h @ w4.astype(f32)).reshape(L, 2, HY_ORDER, HY_WIDTH)
    max_decay = math.log(HY_DECAY_TARGET) / HY_FAST_DECAY
    min_decay = math.log(HY_DECAY_TARGET) / HY_SLOW_DECAY
    deltas = jnp.abs(jnp.linspace(min_decay, max_decay, HY_WIDTH, dtype=f32))
    window = jnp.exp(-t_norm[:, None] * deltas[None, :])
    h = h * window[:, None, None, :]
    h_fwd = h[:, 0]
    h_bwd = h[1:, 1]
    l1 = jnp.sum(jnp.abs(h_fwd), axis=0) + jnp.sum(jnp.abs(h_bwd), axis=0)
    kern = jnp.concatenate(
        [h_fwd, jnp.zeros((1, HY_ORDER, HY_WIDTH), f32), h_bwd[::-1]], axis=0) / l1
    return jnp.fft.rfft(kern, axis=0)


def fft_long_conv(z, k_f):
    S = z.shape[1]
    zf = jnp.fft.rfft(z.astype(jnp.float32), n=2 * S, axis=1)
    y = jnp.fft.irfft(zf * k_f[None], n=2 * S, axis=1)[:, :S]
    return y.astype(z.dtype)


def short_conv_centered(u, w, b):
    up = jnp.pad(u, ((0, 0), (1, 1), (0, 0)))
    return up[:, :-2] * w[0] + up[:, 1:-1] * w[1] + up[:, 2:] * w[2] + b


def hyena_mixer(u, conv_w, conv_b, w1, b1, w2, b2, w3, b3, w4, freq, bias, pos_feat, t_norm):
    u = short_conv_centered(u, conv_w, conv_b)
    x1, x2, v = jnp.split(u, 3, axis=-1)
    k_f = hyena_filters(pos_feat, t_norm, w1, b1, w2, b2, w3, b3, w4, freq)
    z = v
    for o, gate in enumerate((x1, x2)):
        z = gate * (fft_long_conv(z, k_f[:, o]) + z * bias[o])
    return z


def rope(x, cos, sin):
    half = x.shape[-1] // 2
    x1, x2 = x[..., :half], x[..., half:]
    return jnp.concatenate([x1 * cos - x2 * sin, x2 * cos + x1 * sin], axis=-1)


def retention_log_decay(offset):
    return jnp.log(1.0 - jnp.exp2(-(offset + jnp.arange(RET_HEADS, dtype=jnp.float32))))


def retention_one_direction(q, k, v, log_gamma, include_diag):
    B, H, S, DK = q.shape
    DV = v.shape[-1]
    C = RET_CHUNK
    N = S // C
    qc = q.reshape(B, H, N, C, DK)
    kc = k.reshape(B, H, N, C, DK)
    vc = v.reshape(B, H, N, C, DV)
    pos = jnp.arange(C, dtype=jnp.float32)
    diff = pos[:, None] - pos[None, :]
    mask = (diff >= 0) if include_diag else (diff > 0)
    decay = jnp.where(mask[None], jnp.exp(jnp.where(mask, diff, 0.0)[None] * log_gamma[:, None, None]), 0.0)
    scores = jnp.einsum('bhnid,bhnjd->bhnij', qc, kc) * decay[None, :, None]
    inner = jnp.einsum('bhnij,bhnjv->bhniv', scores, vc)
    k_w = jnp.exp((C - 1 - pos)[None, :] * log_gamma[:, None])
    chunk_sum = jnp.einsum('bhnjd,hj,bhnjv->bhndv', kc, k_w, vc)
    chunk_decay = jnp.exp(C * log_gamma)[None, :, None, None]

    def step(state, u):
        return state * chunk_decay + u, state

    init = jnp.zeros((B, H, DK, DV), chunk_sum.dtype)
    _, prev = lax.scan(step, init, jnp.moveaxis(chunk_sum, 2, 0))
    prev = jnp.moveaxis(prev, 0, 2)
    q_w = jnp.exp((pos + 1.0)[None, :] * log_gamma[:, None])
    cross = jnp.einsum('bhnid,hi,bhndv->bhniv', qc, q_w, prev)
    return (inner + cross).reshape(B, H, S, DV)


def retention_mixer(q, k, v, g, cos, sin):
    B, S, _ = q.shape

    def heads(t, d):
        return t.reshape(B, S, RET_HEADS, d).transpose(0, 2, 1, 3)

    qh = rope(heads(q, RET_DK), cos, sin)
    kh = rope(heads(k, RET_DK), cos, sin) * (RET_DK ** -0.5)
    vh = heads(v, RET_DV)
    fwd = retention_one_direction(qh, kh, vh, retention_log_decay(RET_DECAY_FWD), True)
    flip = lambda t: jnp.flip(t, axis=2)
    bwd = flip(retention_one_direction(flip(qh), flip(kh), flip(vh), retention_log_decay(RET_DECAY_BWD), False))
    o = (fwd + bwd).astype(jnp.float32)
    o = o * lax.rsqrt(jnp.mean(o * o, axis=-1, keepdims=True) + EPS)
    o = o.astype(q.dtype).transpose(0, 2, 1, 3).reshape(B, S, RET_V)
    return jax.nn.silu(g) * o


def mixer_block(h, w_in, hy_conv_w, hy_conv_b, hy_w1, hy_b1, hy_w2, hy_b2, hy_w3, hy_b3, hy_w4,
                hy_freq, hy_bias, w_hy_br, w_ret_br, w_out, pos_feat, t_norm, cos, sin):
    proj = h @ w_in
    s0 = 3 * HY_WIDTH
    s1 = s0 + RET_QK
    s2 = s1 + RET_QK
    s3 = s2 + RET_V
    s4 = s3 + RET_V
    u_hy, q, k, v, g_ret, g_merge = jnp.split(proj, [s0, s1, s2, s3, s4], axis=-1)
    y_hy = hyena_mixer(u_hy, hy_conv_w, hy_conv_b, hy_w1, hy_b1, hy_w2, hy_b2, hy_w3, hy_b3,
                       hy_w4, hy_freq, hy_bias, pos_feat, t_norm)
    y_ret = retention_mixer(q, k, v, g_ret, cos, sin)
    g_hy, g_rt = jnp.split(jax.nn.sigmoid(g_merge.astype(jnp.float32)).astype(h.dtype), N_BRANCH, axis=-1)
    merged = g_hy * (y_hy @ w_hy_br) + g_rt * (y_ret @ w_ret_br)
    return merged @ w_out


def moe_ffn(h, w_router, b_router, w_gate_up, b_gate_up, w_down, b_down):
    B, S, D = h.shape
    T = B * S
    xs = h.reshape(T, D)
    logits = (xs @ w_router + b_router).astype(jnp.float32)
    top_val, top_idx = lax.top_k(logits, TOP_K)
    gates = jax.nn.softmax(top_val, axis=-1)
    n_assign = T * TOP_K
    flat_e = top_idx.reshape(-1).astype(jnp.int32)
    flat_tok = (jnp.arange(n_assign, dtype=jnp.int32) // TOP_K)
    flat_g = gates.reshape(-1)
    order = jnp.argsort(flat_e, stable=True)
    se, stok, sg = flat_e[order], flat_tok[order], flat_g[order]
    counts = jnp.bincount(flat_e, length=N_EXPERTS)
    starts = jnp.cumsum(counts) - counts
    padded = ((counts + MOE_BLOCK - 1) // MOE_BLOCK) * MOE_BLOCK
    pad_ends = jnp.cumsum(padded)
    pad_starts = pad_ends - padded
    dest = (pad_starts[se] + jnp.arange(n_assign) - starts[se]).astype(jnp.int32)
    n_blocks = -(-(n_assign + N_EXPERTS * (MOE_BLOCK - 1)) // MOE_BLOCK)
    P = n_blocks * MOE_BLOCK
    slot_tok = jnp.full((P,), T, jnp.int32).at[dest].set(stok)
    xs_pad = jnp.concatenate([xs, jnp.zeros((1, D), xs.dtype)], axis=0)
    xb = xs_pad[slot_tok].reshape(n_blocks, MOE_BLOCK, D)
    block_e = jnp.minimum(
        jnp.searchsorted(pad_ends, jnp.arange(n_blocks) * MOE_BLOCK, side='right'), N_EXPERTS - 1)

    def expert_block(args):
        xblk, e = args
        gu = xblk @ w_gate_up[e] + b_gate_up[e]
        gate = jnp.minimum(gu[:, 0::2], SWIGLU_LIMIT)
        up = jnp.clip(gu[:, 1::2], -SWIGLU_LIMIT, SWIGLU_LIMIT)
        act = (up + 1.0) * (gate * jax.nn.sigmoid(SWIGLU_ALPHA * gate))
        return act @ w_down[e] + b_down[e]

    yb = lax.map(expert_block, (xb, block_e)).reshape(P, D)
    contrib = yb[dest].astype(jnp.float32) * sg[:, None]
    out = jax.ops.segment_sum(contrib, stok, num_segments=T)
    return out.astype(h.dtype).reshape(B, S, D)


def setup_inputs(seed: int = 0) -> dict:
    key = jax.random.key(seed)
    ks = jax.random.split(key, 32)
    f32 = jnp.float32
    L, D, E, F = DEPTH, D_MODEL, N_EXPERTS, D_FF

    def nrm(k, shape, scale):
        return jax.random.normal(k, shape, f32) * scale

    return {
        "x": nrm(ks[0], (BATCH, SEQ, D), 1.0),
        "c": nrm(ks[1], (BATCH, D), 1.0),
        "norm_mix_g": 1.0 + nrm(ks[2], (L, D), 0.01),
        "norm_ffn_g": 1.0 + nrm(ks[3], (L, D), 0.01),
        "w_mod": nrm(ks[4], (L, D, N_MOD * D), 0.5 * D ** -0.5),
        "b_mod": nrm(ks[5], (L, N_MOD * D), 0.01),
        "w_in": nrm(ks[6], (L, D, IN_COLS), D ** -0.5),
        "hy_conv_w": nrm(ks[7], (L, 3, 3 * HY_WIDTH), 3 ** -0.5),
        "hy_conv_b": nrm(ks[8], (L, 3 * HY_WIDTH), 0.01),
        "hy_w1": nrm(ks[9], (L, HY_EMB, HY_FILT_HIDDEN), HY_EMB ** -0.5),
        "hy_b1": nrm(ks[10], (L, HY_FILT_HIDDEN), 0.1),
        "hy_w2": nrm(ks[11], (L, HY_FILT_HIDDEN, HY_FILT_HIDDEN), HY_FILT_HIDDEN ** -0.5),
        "hy_b2": nrm(ks[12], (L, HY_FILT_HIDDEN), 0.1),
        "hy_w3": nrm(ks[13], (L, HY_FILT_HIDDEN, HY_FILT_HIDDEN), HY_FILT_HIDDEN ** -0.5),
        "hy_b3": nrm(ks[14], (L, HY_FILT_HIDDEN), 0.1),
        "hy_w4": nrm(ks[15], (L, HY_FILT_HIDDEN, 2 * HY_ORDER * HY_WIDTH), HY_FILT_HIDDEN ** -0.5),
        "hy_freq": 1.0 + nrm(ks[16], (L, HY_FILT_HIDDEN), 0.1),
        "hy_bias": nrm(ks[17], (L, HY_ORDER, HY_WIDTH), 1.0),
        "w_hy_br": nrm(ks[18], (L, HY_WIDTH, D), HY_WIDTH ** -0.5),
        "w_ret_br": nrm(ks[19], (L, RET_V, D), RET_V ** -0.5),
        "w_out": nrm(ks[20], (L, D, D), D ** -0.5),
        "w_router": nrm(ks[21], (L, D, E), D ** -0.5),
        "b_router": nrm(ks[22], (L, E), 0.01),
        "w_gate_up": nrm(ks[23], (L, E, D, 2 * F), D ** -0.5),
        "b_gate_up": nrm(ks[24], (L, E, 2 * F), 0.01),
        "w_down": nrm(ks[25], (L, E, F, D), F ** -0.5),
        "b_down": nrm(ks[26], (L, E, D), 0.01),
        "final_g": 1.0 + nrm(ks[27], (D,), 0.01),
    }


def reference(x, c, norm_mix_g, norm_ffn_g, w_mod, b_mod, w_in, hy_conv_w, hy_conv_b,
              hy_w1, hy_b1, hy_w2, hy_b2, hy_w3, hy_b3, hy_w4, hy_freq, hy_bias,
              w_hy_br, w_ret_br, w_out, w_router, b_router, w_gate_up, b_gate_up,
              w_down, b_down, final_g):
    S = x.shape[1]
    pos_feat, t_norm = hyena_pos_features(S)
    inv_freq = 1.0 / (ROPE_BASE ** (jnp.arange(0, RET_DK, 2, dtype=jnp.float32) / RET_DK))
    ang = jnp.arange(S, dtype=jnp.float32)[:, None] * inv_freq[None, :]
    cos, sin = jnp.cos(ang), jnp.sin(ang)
    c_act = jax.nn.silu(c)
    for l in range(DEPTH):
        mod = (c_act @ w_mod[l] + b_mod[l])[:, None, :]
        sh_a, sc_a, ga_a, sh_f, sc_f, ga_f = jnp.split(mod, N_MOD, axis=-1)
        h = rms_norm(x, norm_mix_g[l]) * (1.0 + sc_a) + sh_a
        x = x + ga_a * mixer_block(h, w_in[l], hy_conv_w[l], hy_conv_b[l], hy_w1[l], hy_b1[l],
                                   hy_w2[l], hy_b2[l], hy_w3[l], hy_b3[l], hy_w4[l], hy_freq[l],
                                   hy_bias[l], w_hy_br[l], w_ret_br[l], w_out[l],
                                   pos_feat, t_norm, cos, sin)
        h = rms_norm(x, norm_ffn_g[l]) * (1.0 + sc_f) + sh_f
        x = x + ga_f * moe_ffn(h, w_router[l], b_router[l], w_gate_up[l], b_gate_up[l],
                               w_down[l], b_down[l])
    return rms_norm(x, final_g)
```

```cpp
#include <hip/hip_runtime.h>
#include <cstdio>
#include <cstdint>

#define LAS __attribute__((address_space(3)))
typedef unsigned short bf16_t;
typedef short bf16x8 __attribute__((ext_vector_type(8)));
typedef float f32x4 __attribute__((ext_vector_type(4)));
typedef float f32x2 __attribute__((ext_vector_type(2)));
typedef unsigned u32x4 __attribute__((ext_vector_type(4)));
typedef unsigned u32x2 __attribute__((ext_vector_type(2)));

constexpr int D = 1024, NB = 4, S = 8192, T = NB * S, DEPTH = 4;
constexpr int NE = 32, CAP = 32768, FF = 1024;
constexpr int INC = 5120;
constexpr int P1R = 2048, P2C = 3072;
constexpr int NSLOT = T * 4 + NE * 256;
constexpr float EPS = 1e-6f;
constexpr int NT = 512;
constexpr int LDS_BYTES = 163840;
constexpr int LDS_TAB = 131072;

enum { I_X = 0, I_C, I_NMG, I_NFG, I_WMOD, I_BMOD, I_WIN, I_CW, I_CB, I_W1, I_B1, I_W2, I_B2, I_W3, I_B3, I_W4, I_FREQ, I_HBIAS,
       I_WHY, I_WRET, I_WOUT, I_WR, I_BR, I_WGU, I_BGU, I_WDN, I_BDN, I_FG, N_IN };

constexpr size_t MiB = 1u << 20;
constexpr size_t WS_CTL = 0, CTL_BYTES = 1 * MiB;
constexpr size_t WS_MOD = 1 * MiB;
constexpr size_t WS_ROPE = 2 * MiB;
constexpr size_t WS_L1P = 4 * MiB;
constexpr size_t WS_WIN1 = 12 * MiB;
constexpr size_t WS_WIN2 = 28 * MiB;
constexpr size_t WS_H8A = 2443 * MiB + 32 * MiB;
constexpr size_t WS_WHY = 52 * MiB;
constexpr size_t WS_WRET = 56 * MiB;
constexpr size_t WS_WOUT = 60 * MiB;
constexpr size_t WS_WGU = 68 * MiB;
constexpr size_t WS_WDN = 580 * MiB;
constexpr size_t WS_KT = 836 * MiB;
constexpr size_t WS_X = 1092 * MiB;
constexpr size_t WS_H = 1220 * MiB;
constexpr size_t WS_P1 = 1284 * MiB;
constexpr size_t WS_P2 = 1412 * MiB;
constexpr size_t WS_YHYT = 1604 * MiB;
constexpr size_t WS_YHY = 1636 * MiB;
constexpr size_t WS_YRET = 1668 * MiB;
constexpr size_t WS_M1 = 1700 * MiB;
constexpr size_t WS_MRG = 1764 * MiB;
constexpr size_t WS_TOKE = 1828 * MiB;
constexpr size_t WS_TOKG = 1829 * MiB;
constexpr size_t WS_TOKP = 1830 * MiB;
constexpr size_t WS_SLOT = 1831 * MiB;
constexpr size_t WS_ACT = 1835 * MiB;
constexpr size_t WS_YB = 2107 * MiB;
constexpr size_t WS_KVS = 2379 * MiB;
constexpr size_t WS_KVP = 2443 * MiB;
constexpr size_t WS_KF = 2507 * MiB;
constexpr size_t WS_G8 = 3019 * MiB;
constexpr size_t WS_END = 3083 * MiB;
constexpr int CW_BAR = 4096;
constexpr int CW_CNT = 16384;

struct Params { const float* in[N_IN]; float* out; unsigned char* ws; int phase; int layer; };

typedef __bf16 bf16x2_nat_ __attribute__((ext_vector_type(2)));
__device__ __forceinline__ unsigned pk2(float lo, float hi) { const bf16x2_nat_ v = {(__bf16)lo, (__bf16)hi}; return __builtin_bit_cast(unsigned, v); }
__device__ __forceinline__ unsigned f2bf(float f) { return pk2(f, 0.0f) & 0xffffu; }
__device__ __forceinline__ float bf_lo(unsigned w) { return __uint_as_float(w << 16); }
__device__ __forceinline__ float bf_hi(unsigned w) { return __uint_as_float(w & 0xffff0000u); }
__device__ __forceinline__ f32x4 bf4_to_f32(const u32x2 w) { return (f32x4){bf_lo(w.x), bf_hi(w.x), bf_lo(w.y), bf_hi(w.y)}; }
__device__ __forceinline__ float bf2f(bf16_t b) { return __uint_as_float(((unsigned)b) << 16); }
template <int M> __device__ __forceinline__ float swz_xor(float v) { return __int_as_float(__builtin_amdgcn_ds_swizzle(__float_as_int(v), (M << 10) | 0x1F)); }
template <int M> __device__ __forceinline__ int swz_xor_i(int v) { return __builtin_amdgcn_ds_swizzle(v, (M << 10) | 0x1F); }
__device__ __forceinline__ float xor32(float v, int lane) { return __int_as_float(__builtin_amdgcn_ds_bpermute((lane ^ 32) << 2, __float_as_int(v))); }
__device__ __forceinline__ int xor32_i(int v, int lane) { return __builtin_amdgcn_ds_bpermute((lane ^ 32) << 2, v); }
__device__ __forceinline__ float lane_prev(float v) { return __int_as_float(__builtin_amdgcn_update_dpp(0, __float_as_int(v), 0x138, 0xF, 0xF, true)); }
__device__ __forceinline__ float lane_next(float v) { return __int_as_float(__builtin_amdgcn_update_dpp(0, __float_as_int(v), 0x130, 0xF, 0xF, true)); }
template <int CTRL> __device__ __forceinline__ float dpp_f(float v) { return __int_as_float(__builtin_amdgcn_update_dpp(0, __float_as_int(v), CTRL, 0xF, 0xF, true)); }
template <int CTRL> __device__ __forceinline__ int dpp_i(int v) { return __builtin_amdgcn_update_dpp(0, v, CTRL, 0xF, 0xF, true); }
constexpr int DPP_X1 = 0xB1, DPP_X2 = 0x4E, DPP_HM = 0x141, DPP_RM = 0x140;
__device__ __forceinline__ float half_sum(float v) { v += dpp_f<DPP_X1>(v); v += dpp_f<DPP_X2>(v); v += dpp_f<DPP_HM>(v); v += dpp_f<DPP_RM>(v); v += swz_xor<16>(v); return v; }
__device__ __forceinline__ float wave_sum(float v, int lane) { v = half_sum(v); return v + xor32(v, lane); }
__device__ __forceinline__ float sigmoidf_(float x) { return __builtin_amdgcn_rcpf(1.0f + __builtin_amdgcn_exp2f(x * -1.4426950408889634f)); }
__device__ __forceinline__ float sigmoid_fast(float x) { return sigmoidf_(x); }
#define LDS_WAIT() asm volatile("s_waitcnt lgkmcnt(0)" ::: "memory")
#define VM_WAIT() asm volatile("s_waitcnt vmcnt(0)" ::: "memory")

struct Ctx {
    LAS unsigned char* lds;
    int tid, lane, wave, bid, G, vcu;
    unsigned char* ws;
};
typedef const __attribute__((address_space(4))) Params* KP;
__device__ __forceinline__ KP get_kp() { KP kp = (KP)__builtin_amdgcn_kernarg_segment_ptr(); asm volatile("" : "+s"(kp)); return kp; }
#define PH_ENTER() KP p = get_kp(); Ctx c; { int w_ = c0.wave; asm volatile("" : "+s"(w_)); unsigned m_ = ~0u; asm volatile("" : "+s"(m_)); int t_ = w_ * 64 + (int)__builtin_amdgcn_mbcnt_hi(m_, __builtin_amdgcn_mbcnt_lo(m_, 0u)); asm volatile("" : "+v"(t_)); \
    c.tid = t_; c.lane = t_ & 63; c.wave = w_; c.ws = p->ws; \
    unsigned lb_ = (unsigned)(uintptr_t)c0.lds; int b_ = c0.bid, g_ = c0.G; asm volatile("" : "+s"(lb_), "+s"(b_), "+s"(g_)); c.lds = (LAS unsigned char*)(uintptr_t)lb_; c.bid = b_; c.G = g_; \
    c.vcu = (g_ % 8 == 0) ? (b_ % 8) * (g_ / 8) + b_ / 8 : b_; }

#define XB_TMO      128
#define XB_XCNT(j)  (256  + 64 * (j))
#define XB_XSUB(j)  (1280 + 64 * (j))
#define XB_XGEN(j)  (2304 + 64 * (j))
#define XB_TOP      3328
#define XB_TOPGEN   3392
#define XCD_BAR_WORDS 3456
#define XB_SPIN_CAP (1u << 18)
__device__ __forceinline__ unsigned xb_ld(unsigned* p)              { return __hip_atomic_load(p, __ATOMIC_RELAXED, __HIP_MEMORY_SCOPE_AGENT); }
__device__ __forceinline__ unsigned xb_add(unsigned* p, unsigned v) { return __hip_atomic_fetch_add(p, v, __ATOMIC_RELAXED, __HIP_MEMORY_SCOPE_AGENT); }
__device__ __forceinline__ unsigned xb_xcc_id() { return (unsigned)__builtin_amdgcn_s_getreg((3 << 11) | 20) & 0xFu; }
#define XB_SPIN(cond, bar) do { unsigned _sp = 0; while (cond) { __builtin_amdgcn_s_sleep(1); \
    if ((++_sp & 255u) == 0u) { if (xb_ld(&(bar)[XB_TMO])) break; if (_sp > XB_SPIN_CAP) { atomicAdd(&(bar)[XB_TMO], 1u); break; } } } } while (0)
struct XcdBarrier { unsigned* bar; unsigned x; volatile LAS unsigned* st; };
__device__ __forceinline__ XcdBarrier xcd_barrier_post(unsigned* bar, volatile LAS unsigned* st) {
    XcdBarrier b; b.bar = bar; b.x = xb_xcc_id(); b.st = st;
    if (threadIdx.x == 0) (void)xb_add(&bar[XB_XCNT(b.x)], 1u);
    return b;
}
__device__ __forceinline__ void xcd_barrier_complete(unsigned* bar, unsigned x, unsigned& nloc, unsigned& nx) {
    const unsigned G = gridDim.x * gridDim.y * gridDim.z;
    unsigned sum, cnt, mine, sp = 0u;
    for (;;) {
        sum = 0u; cnt = 0u; mine = 0u;
#pragma unroll
        for (unsigned j = 0; j < 16; ++j) { const unsigned c = xb_ld(&bar[XB_XCNT(j)]); sum += c; cnt += (c > 0u) ? 1u : 0u; mine = (j == x) ? c : mine; }
        if (sum == G) break;
        __builtin_amdgcn_s_sleep(1);
        if ((++sp & 255u) == 0u) { if (xb_ld(&bar[XB_TMO])) break; if (sp > XB_SPIN_CAP) { atomicAdd(&bar[XB_TMO], 1u); break; } }
    }
    nloc = mine > 0u ? mine : 1u; nx = cnt > 0u ? cnt : 1u;
}
__device__ __forceinline__ void xcd_barrier(const XcdBarrier& b, const bool leader) {
    asm volatile("s_waitcnt vmcnt(0)" ::: "memory");
    __syncthreads();
    if (leader) {
        unsigned* bar = b.bar;
        __builtin_amdgcn_s_waitcnt(0);
        unsigned nloc = b.st[0], nx = b.st[1];
        if (nloc == 0u) { xcd_barrier_complete(bar, b.x, nloc, nx); b.st[0] = nloc; b.st[1] = nx; }
        const unsigned old = xb_add(&bar[XB_XSUB(b.x)], 1u);
        const unsigned gen = old / nloc;
        if (old + 1u == (gen + 1u) * nloc) {
            __builtin_amdgcn_fence(__ATOMIC_RELEASE, "agent");
            asm volatile("s_waitcnt vmcnt(0)" ::: "memory");
            const unsigned og = xb_add(&bar[XB_TOP], 1u);
            const unsigned tg = og / nx;
            if (og + 1u == (tg + 1u) * nx) xb_add(&bar[XB_TOPGEN], 1u);
            else XB_SPIN(xb_ld(&bar[XB_TOPGEN]) == tg, bar);
            __builtin_amdgcn_fence(__ATOMIC_ACQUIRE, "agent");
            xb_add(&bar[XB_XGEN(b.x)], 1u);
            asm volatile("s_waitcnt vmcnt(0)" ::: "memory");
        } else {
            XB_SPIN(xb_ld(&bar[XB_XGEN(b.x)]) == gen, bar);
            __builtin_amdgcn_fence(__ATOMIC_ACQUIRE, "agent");
            asm volatile("s_waitcnt vmcnt(0)" ::: "memory");
        }
    }
    __syncthreads();
}

namespace pg8 {
constexpr int BM = 256, BK = 64, HALF = 128, HTB = HALF * BK * 2, STAGE_BYTES = 8 * HTB, NXCD = 8, WGM = 8;
__host__ __device__ __forceinline__ int lds_byte(int r, int c) { const int st = (r >> 4) * 2 + (c >> 5), rr = r & 15, cc = c & 31, ob = rr * 64 + cc * 2; return st * 1024 + (ob ^ (((ob >> 9) & 1) << 5)); }
__host__ __device__ __forceinline__ void stage_rc(int b, int& R, int& C) { const int st = b / 1024, sb = b % 1024, swz = sb ^ (((sb >> 9) & 1) << 5); R = (st >> 1) * 16 + swz / 64; C = (st & 1) * 32 + (swz % 64) / 2; }
__host__ __device__ __forceinline__ int perm32(int rho) { const int n = rho >> 4, i = rho & 15; return 8 * (i >> 2) + 4 * n + (i & 3); }

struct Unit { int pm, pn, e; };
struct Gemm { const bf16_t* A; const bf16_t* Bt; int lda, ldb, K; size_t bstride; size_t astride = 0; };

struct StaticOrder {
    int nM, nN, nwg, G, c;
    __host__ __device__ void init(int M, int N, int G_, int c_) { nM = M / BM; nN = N / BM; nwg = nM * nN; G = G_; c = c_; }
    __host__ __device__ bool next(int i, Unit& u) const {
        const long L = (long)i * G + c; if (L >= nwg) return false;
        int wgid = (int)L; { const int q = nwg / NXCD, r = nwg % NXCD, xcd = wgid % NXCD, off = wgid / NXCD; wgid = (xcd < r ? xcd * (q + 1) : r * (q + 1) + (xcd - r) * q) + off; }
        const int nig = WGM * nN, gid = wgid / nig, fm = gid * WGM, gsz = (nM - fm) < WGM ? (nM - fm) : WGM;
        u.pm = fm + ((wgid % nig) % gsz); u.pn = (wgid % nig) / gsz; u.e = 0; return true;
    }
};
struct PairOrder : StaticOrder {
    __host__ __device__ bool next(int i, Unit& u) const { if (!StaticOrder::next(i >> 1, u)) return false; u.e = i & 1; return true; }
};
struct MoeOrder {
    int nM, nN, nwg, G, c; const LAS int* tile_e;
    __device__ void init(int nM_, int nN_, int G_, int c_, const LAS int* te) { nM = nM_; nN = nN_; nwg = nM * nN; G = G_; c = c_; tile_e = te; }
    __device__ bool next(int i, Unit& u) const {
        const long L = (long)i * G + c; if (L >= nwg) return false;
        int wgid = (int)L; { const int q = nwg / NXCD, r = nwg % NXCD, xcd = wgid % NXCD, off = wgid / NXCD; wgid = (xcd < r ? xcd * (q + 1) : r * (q + 1) + (xcd - r) * q) + off; }
        const int nig = WGM * nN, gid = wgid / nig, fm = gid * WGM, gsz = (nM - fm) < WGM ? (nM - fm) : WGM;
        u.pm = fm + ((wgid % nig) % gsz); u.pn = (wgid % nig) / gsz; u.e = tile_e[u.pm]; return true;
    }
};

typedef __bf16 bf16x2_native __attribute__((ext_vector_type(2)));
__device__ __forceinline__ unsigned cvt_pk_bf16(float lo, float hi) { const bf16x2_native v = {(__bf16)lo, (__bf16)hi}; return __builtin_bit_cast(unsigned, v); }

typedef int i32x4_t __attribute__((ext_vector_type(4)));
typedef int i32x8_t __attribute__((ext_vector_type(8)));
__device__ __forceinline__ i32x8_t cat8(const bf16x8 a, const bf16x8 b) { return __builtin_shufflevector(__builtin_bit_cast(i32x4_t, a), __builtin_bit_cast(i32x4_t, b), 0, 1, 2, 3, 4, 5, 6, 7); }
template <class Epi, class Sched, bool GATHER, bool F8 = false>
__device__ __forceinline__ void gemm_phase(LAS unsigned char* lds, const Gemm g, const Sched& S, const Epi& E, const LAS int* rowtab, const int tid) {
    const int wid = __builtin_amdgcn_readfirstlane(tid >> 6), lane = tid & 63, wr = wid >> 2, wc = wid & 3, fr = lane & 15, fq = lane >> 4;
    const int K = g.K, nt = K / BK;
    unsigned voffB[2], voffA[2][2], go[2] = {0u, 0u}; int gRC = 0;
#pragma unroll
    for (int i = 0; i < 2; ++i) { int R, C; stage_rc(tid * 16 + i * 8192, R, C); const int Rb = Epi::PERM ? ((R & ~31) + perm32(R & 31)) : R;
        voffB[i] = (unsigned)(Rb * g.ldb + C) * 2u;
#pragma unroll
        for (int h = 0; h < 2; ++h) voffA[h][i] = (unsigned)((h * HALF + R) * g.lda + C) * 2u; if (i == 0) gRC = R | (C << 8); }
    const size_t kstep = (size_t)(BK * 2);
    const size_t hstepB = (size_t)HALF * g.ldb * 2; const unsigned hstepA32 = (unsigned)(HALF * g.lda * 2);
    const size_t tstepA = (size_t)BM * g.lda * 2, tstepB = (size_t)BM * g.ldb * 2;
    const unsigned ldsw = (unsigned)wid * 1024u;
    const int aoff = lds_byte(wr * 64 + fr, fq * 8), boff = lds_byte(wc * 32 + fr, fq * 8);
#define PG8_SA(b, h) (((b) * 2 + (h)) * HTB)
#define PG8_SB(b, h) ((4 + (b) * 2 + (h)) * HTB)
#define PG8_STAGE_B(bufoff, gbase, h) do { _Pragma("unroll") for (int _i = 0; _i < 2; ++_i) { unsigned _o = voffB[_i]; asm volatile("" : "+v"(_o)); \
        __builtin_amdgcn_global_load_lds((const unsigned*)((const char*)(gbase) + (h) * hstepB + _o), (LAS unsigned*)(lds + (bufoff) + ldsw + _i * 8192), 16, 0, 0); } } while (0)
#define PG8_STAGE_A(bufoff, gbase, h) do { _Pragma("unroll") for (int _i = 0; _i < 2; ++_i) { unsigned _o = GATHER ? go[_i] : voffA[0][_i]; asm volatile("" : "+v"(_o)); if (!GATHER) _o += (unsigned)(h) * hstepA32; \
        __builtin_amdgcn_global_load_lds((const unsigned*)((const char*)(gbase) + _o), (LAS unsigned*)(lds + (bufoff) + ldsw + _i * 8192), 16, 0, 0); } } while (0)
#define PG8_LDA(dst, b, h) do { _Pragma("unroll") for (int m = 0; m < 4; ++m) dst[m] = __builtin_shufflevector(*(const LAS i32x4_t*)(lds + PG8_SA(b, h) + aoff + m * 2048), *(const LAS i32x4_t*)(lds + PG8_SA(b, h) + aoff + m * 2048 + 1024), 0, 1, 2, 3, 4, 5, 6, 7); } while (0)
#define PG8_LDB(dst, b, h) do { _Pragma("unroll") for (int n = 0; n < 2; ++n) dst[n] = __builtin_shufflevector(*(const LAS i32x4_t*)(lds + PG8_SB(b, h) + boff + n * 2048), *(const LAS i32x4_t*)(lds + PG8_SB(b, h) + boff + n * 2048 + 1024), 0, 1, 2, 3, 4, 5, 6, 7); } while (0)
#define PG8_LO(v) __builtin_bit_cast(bf16x8, __builtin_shufflevector(v, v, 0, 1, 2, 3))
#define PG8_HI(v) __builtin_bit_cast(bf16x8, __builtin_shufflevector(v, v, 4, 5, 6, 7))
#define PG8_MMA(ai, bj, At, Bt) do { __builtin_amdgcn_s_setprio(1); if constexpr (F8) { _Pragma("unroll") for (int m = 0; m < 4; ++m) _Pragma("unroll") for (int n = 0; n < 2; ++n) \
        acc[ai][bj][m][n] = __builtin_amdgcn_mfma_scale_f32_16x16x128_f8f6f4(Bt[n], At[m], acc[ai][bj][m][n], 0, 0, 0, 0, 0, 0); } else { \
        _Pragma("unroll") for (int m = 0; m < 4; ++m) _Pragma("unroll") for (int n = 0; n < 2; ++n) { \
        acc[ai][bj][m][n] = __builtin_amdgcn_mfma_f32_16x16x32_bf16(PG8_LO(Bt[n]), PG8_LO(At[m]), acc[ai][bj][m][n], 0, 0, 0); \
        acc[ai][bj][m][n] = __builtin_amdgcn_mfma_f32_16x16x32_bf16(PG8_HI(Bt[n]), PG8_HI(At[m]), acc[ai][bj][m][n], 0, 0, 0); } } __builtin_amdgcn_s_setprio(0); } while (0)
#define PG8_WAIT_V(n) asm volatile("s_waitcnt vmcnt(" #n ")" ::: "memory")
#define PG8_WAIT_L(n) asm volatile("s_waitcnt lgkmcnt(" #n ")" ::: "memory")
#define PG8_BAR __builtin_amdgcn_s_barrier()
#define PG8_SCHED __builtin_amdgcn_sched_barrier(0)
#define PG8_GO(un_, h_) do { if constexpr (GATHER) { _Pragma("unroll") for (int _i = 0; _i < 2; ++_i) go[_i] = (unsigned)(rowtab[(un_) * BM + (h_) * HALF + (gRC & 255) + 64 * _i] * g.lda + (gRC >> 8)) * 2u; } } while (0)
    Unit cur, nxt; int ui = 0;
    if (!S.next(0, cur)) return;
    f32x4 acc[2][2][4][2];
#pragma unroll
    for (int a = 0; a < 2; ++a)
#pragma unroll
        for (int b = 0; b < 2; ++b)
#pragma unroll
            for (int m = 0; m < 4; ++m)
#pragma unroll
                for (int n = 0; n < 2; ++n) acc[a][b][m][n] = (f32x4){0.f, 0.f, 0.f, 0.f};
    i32x8_t At[4], B0[2], B1[2];
    const char* cA = (const char*)g.A + (GATHER ? (size_t)0 : (size_t)cur.e * g.astride * 2 + (size_t)cur.pm * tstepA);
    const char* cB = (const char*)g.Bt + (size_t)cur.e * g.bstride * 2 + (size_t)cur.pn * tstepB;
    PG8_STAGE_B(PG8_SB(0, 0), cB, 0); PG8_STAGE_B(PG8_SB(0, 1), cB, 1); PG8_GO(0, 0); PG8_STAGE_A(PG8_SA(0, 0), cA, 0); PG8_GO(0, 1); PG8_STAGE_A(PG8_SA(0, 1), cA, 1);
    if (wr == 1) PG8_BAR;
    PG8_WAIT_V(2); PG8_BAR;
    PG8_STAGE_B(PG8_SB(1, 0), cB + kstep, 0); PG8_GO(0, 0); PG8_STAGE_A(PG8_SA(1, 0), cA + kstep, 0); PG8_STAGE_B(PG8_SB(1, 1), cB + kstep, 1);
    PG8_WAIT_V(6); PG8_BAR;
    for (;;) {
        const bool has_next = S.next(ui + 1, nxt);
        const char* nA = has_next ? (const char*)g.A + (GATHER ? (size_t)0 : (size_t)nxt.e * g.astride * 2 + (size_t)nxt.pm * tstepA) : cA;
        const char* nB = has_next ? (const char*)g.Bt + (size_t)nxt.e * g.bstride * 2 + (size_t)nxt.pn * tstepB : cB;
#pragma unroll 1
        for (int t = 0; t < nt; t += 2) {
            const bool last = (t == nt - 2);
            const int un = (last && has_next) ? ui + 1 : ui;
            const char* a1 = cA + (size_t)(t + 1) * kstep;
            const char* a2 = last ? nA : cA + (size_t)(t + 2) * kstep; const char* b2 = last ? nB : cB + (size_t)(t + 2) * kstep;
            const char* a3 = a2 + kstep; const char* b3 = b2 + kstep;
            PG8_GO(ui, 1); PG8_LDB(B0, 0, 0); PG8_LDB(B1, 0, 1); PG8_SCHED; PG8_LDA(At, 0, 0); PG8_STAGE_A(PG8_SA(1, 1), a1, 1);
            PG8_WAIT_V(8); PG8_WAIT_L(0); PG8_BAR; PG8_MMA(0, 0, At, B0); PG8_MMA(0, 1, At, B1); PG8_BAR; PG8_SCHED;
            PG8_GO(un, 0); PG8_LDA(At, 0, 1); PG8_STAGE_B(PG8_SB(0, 0), b2, 0); PG8_STAGE_B(PG8_SB(0, 1), b2, 1); PG8_STAGE_A(PG8_SA(0, 0), a2, 0);
            PG8_WAIT_V(8); PG8_WAIT_L(0); PG8_BAR; PG8_MMA(1, 0, At, B0); PG8_MMA(1, 1, At, B1); PG8_BAR; PG8_SCHED;
            PG8_GO(un, 1); PG8_LDB(B0, 1, 0); PG8_LDB(B1, 1, 1); PG8_SCHED; PG8_LDA(At, 1, 0); PG8_STAGE_A(PG8_SA(0, 1), a2, 1);
            PG8_WAIT_V(8); PG8_WAIT_L(0); PG8_BAR; PG8_MMA(0, 0, At, B0); PG8_MMA(0, 1, At, B1); PG8_BAR; PG8_SCHED;
            PG8_GO(un, 0); PG8_LDA(At, 1, 1); PG8_STAGE_B(PG8_SB(1, 0), b3, 0); PG8_STAGE_B(PG8_SB(1, 1), b3, 1); PG8_STAGE_A(PG8_SA(1, 0), a3, 0);
            PG8_WAIT_V(8); PG8_WAIT_L(0); PG8_BAR; PG8_MMA(1, 0, At, B0); PG8_MMA(1, 1, At, B1); PG8_BAR; PG8_SCHED;
        }
        if (wr == 0) PG8_BAR;
        { unsigned me_ = ~0u; asm volatile("" : "+s"(me_)); const int te_ = (int)__builtin_amdgcn_mbcnt_hi(me_, __builtin_amdgcn_mbcnt_lo(me_, 0u));
          E(acc, cur, wr, wc, te_ & 15, (te_ & 63) >> 4); }
        if (!has_next) break;
        if (!(Epi::CHAIN && cur.e == 0)) {
#pragma unroll
        for (int a = 0; a < 2; ++a)
#pragma unroll
            for (int b = 0; b < 2; ++b)
#pragma unroll
                for (int m = 0; m < 4; ++m)
#pragma unroll
                    for (int n = 0; n < 2; ++n) acc[a][b][m][n] = (f32x4){0.f, 0.f, 0.f, 0.f}; }
        cur = nxt; cA = nA; cB = nB; ++ui;
        if (wr == 1) PG8_BAR;
    }
    PG8_WAIT_V(0);
    PG8_BAR;
#undef PG8_SA
#undef PG8_SB
#undef PG8_STAGE_A
#undef PG8_STAGE_B
#undef PG8_LDA
#undef PG8_LDB
#undef PG8_MMA
#undef PG8_WAIT_V
#undef PG8_WAIT_L
#undef PG8_BAR
#undef PG8_SCHED
#undef PG8_GO
}
}
namespace pg8 {
#define EPI_ROW(u, ai, m) ((u).pm * BM + (ai) * HALF + wr * 64 + (m) * 16 + fr)
#define EPI_COL8(u, bj) ((u).pn * BM + (bj) * HALF + wc * 32 + 8 * fq)
#define EPI_COL4(u, bj, n) ((u).pn * BM + (bj) * HALF + wc * 32 + 16 * (n) + 4 * fq)
__device__ __forceinline__ u32x4 pack8(const f32x4 v0, const f32x4 v1) { u32x4 w; w.x = cvt_pk_bf16(v0[0], v0[1]); w.y = cvt_pk_bf16(v0[2], v0[3]); w.z = cvt_pk_bf16(v1[0], v1[1]); w.w = cvt_pk_bf16(v1[2], v1[3]); return w; }
__device__ __forceinline__ void unpack8(const u32x4 w, f32x4& v0, f32x4& v1) { v0 = (f32x4){bf_lo(w.x), bf_hi(w.x), bf_lo(w.y), bf_hi(w.y)}; v1 = (f32x4){bf_lo(w.z), bf_hi(w.z), bf_lo(w.w), bf_hi(w.w)}; }

struct EpiPlain {
    static constexpr bool PERM = true, CHAIN = false;
    bf16_t* O; int ldc; float sc;
    __device__ __forceinline__ void operator()(const f32x4 (&acc)[2][2][4][2], const Unit& u, int wr, int wc, int fr, int fq) const {
#pragma unroll
        for (int ai = 0; ai < 2; ++ai)
#pragma unroll
            for (int m = 0; m < 4; ++m) { bf16_t* rowp = O + (size_t)EPI_ROW(u, ai, m) * ldc;
#pragma unroll
                for (int bj = 0; bj < 2; ++bj) *(u32x4*)(rowp + EPI_COL8(u, bj)) = pack8(acc[ai][bj][m][0] * sc, acc[ai][bj][m][1] * sc); }
    }
};
#ifdef NULL_PROBE
struct EpiNull {
    static constexpr bool PERM = true, CHAIN = false;
    __device__ __forceinline__ void operator()(const f32x4 (&acc)[2][2][4][2], const Unit& u, int wr, int wc, int fr, int fq) const {
#pragma unroll
        for (int ai = 0; ai < 2; ++ai)
#pragma unroll
            for (int bj = 0; bj < 2; ++bj)
#pragma unroll
                for (int m = 0; m < 4; ++m) { asm volatile("" :: "v"(acc[ai][bj][m][0]), "v"(acc[ai][bj][m][1])); }
    }
};
#endif
__device__ __forceinline__ unsigned pk4_u8(const f32x4 g) { unsigned w = 0;
    w = __builtin_amdgcn_cvt_pk_u8_f32(g[0] * 256.0f - 0.5f, 0, w); w = __builtin_amdgcn_cvt_pk_u8_f32(g[1] * 256.0f - 0.5f, 1, w);
    w = __builtin_amdgcn_cvt_pk_u8_f32(g[2] * 256.0f - 0.5f, 2, w); w = __builtin_amdgcn_cvt_pk_u8_f32(g[3] * 256.0f - 0.5f, 3, w); return w; }
__device__ __forceinline__ f32x4 unpk4_u8(const unsigned w) { const f32x4 q = {(float)(w & 255u), (float)((w >> 8) & 255u), (float)((w >> 16) & 255u), (float)(w >> 24)}; return q * (1.0f / 256.0f) + (0.5f / 256.0f); }
struct EpiP2 {
    static constexpr bool PERM = true, CHAIN = false;
    bf16_t* O; const float* rope; float sc;
    __device__ __forceinline__ void operator()(const f32x4 (&acc)[2][2][4][2], const Unit& u, int wr, int wc, int fr, int fq) const {
        if (u.pn < 2) {
            const float ksc = (u.pn == 1 ? 0.125f : 1.0f) * sc; const int i0 = ((wc * 32 + 8 * fq) & 63) >> 1;
#pragma unroll
            for (int ai = 0; ai < 2; ++ai) { f32x4 r[4][2];
#pragma unroll
                for (int m = 0; m < 4; ++m) { const int pos = EPI_ROW(u, ai, m) & (S - 1); const f32x4* rp = (const f32x4*)(rope + ((size_t)pos * 32 + i0) * 2); r[m][0] = rp[0]; r[m][1] = rp[1]; }
#pragma unroll
                for (int m = 0; m < 4; ++m) { bf16_t* rowp = O + (size_t)EPI_ROW(u, ai, m) * P2C; const f32x4 r0 = r[m][0], r1 = r[m][1];
#pragma unroll
                    for (int bj = 0; bj < 2; ++bj) { const f32x4 v0 = acc[ai][bj][m][0], v1 = acc[ai][bj][m][1]; f32x4 o0, o1;
                        o0[0] = (v0[0] * r0[0] - v0[1] * r0[1]) * ksc; o0[1] = (v0[1] * r0[0] + v0[0] * r0[1]) * ksc;
                        o0[2] = (v0[2] * r0[2] - v0[3] * r0[3]) * ksc; o0[3] = (v0[3] * r0[2] + v0[2] * r0[3]) * ksc;
                        o1[0] = (v1[0] * r1[0] - v1[1] * r1[1]) * ksc; o1[1] = (v1[1] * r1[0] + v1[0] * r1[1]) * ksc;
                        o1[2] = (v1[2] * r1[2] - v1[3] * r1[3]) * ksc; o1[3] = (v1[3] * r1[2] + v1[2] * r1[3]) * ksc;
                        *(u32x4*)(rowp + EPI_COL8(u, bj)) = pack8(o0, o1); } } }
        } else if (u.pn < 4) {
#pragma unroll
            for (int ai = 0; ai < 2; ++ai)
#pragma unroll
                for (int m = 0; m < 4; ++m) { bf16_t* rowp = O + (size_t)EPI_ROW(u, ai, m) * P2C;
#pragma unroll
                    for (int bj = 0; bj < 2; ++bj) *(u32x4*)(rowp + EPI_COL8(u, bj)) = pack8(acc[ai][bj][m][0] * sc, acc[ai][bj][m][1] * sc); }
        } else { unsigned char* G8 = get_kp()->ws + WS_G8;
#pragma unroll
            for (int ai = 0; ai < 2; ++ai)
#pragma unroll
                for (int m = 0; m < 4; ++m) { unsigned char* rowp = G8 + (size_t)EPI_ROW(u, ai, m) * 2048 - 1024;
#pragma unroll
                    for (int bj = 0; bj < 2; ++bj) { f32x4 v0 = acc[ai][bj][m][0] * sc, v1 = acc[ai][bj][m][1] * sc;
#pragma unroll
                        for (int j = 0; j < 4; ++j) { v0[j] = sigmoidf_(v0[j]); v1[j] = sigmoidf_(v1[j]); }
                        u32x2 w8; w8.x = pk4_u8(v0); w8.y = pk4_u8(v1); *(u32x2*)(rowp + EPI_COL8(u, bj)) = w8; } }
        }
    }
};
struct EpiGate8 {
    static constexpr bool PERM = true, CHAIN = false;
    bf16_t* O;
    __device__ __forceinline__ void operator()(const f32x4 (&acc)[2][2][4][2], const Unit& u, int wr, int wc, int fr, int fq) const {
#pragma unroll
        for (int ai = 0; ai < 2; ++ai)
#pragma unroll
            for (int m = 0; m < 4; ++m) { bf16_t* rowp = O + (size_t)EPI_ROW(u, ai, m) * P2C + 1024;
#pragma unroll
                for (int bj = 0; bj < 2; ++bj) { f32x4 v0 = acc[ai][bj][m][0] * 0.03125f, v1 = acc[ai][bj][m][1] * 0.03125f;
#pragma unroll
                    for (int j = 0; j < 4; ++j) { v0[j] = sigmoid_fast(v0[j]); v1[j] = sigmoid_fast(v1[j]); }
                    *(u32x4*)(rowp + EPI_COL8(u, bj)) = pack8(v0, v1); } }
    }
};
struct EpiHy {
    static constexpr bool PERM = true, CHAIN = false;
    bf16_t* M1; const bf16_t* P2;
    __device__ __forceinline__ void operator()(const f32x4 (&acc)[2][2][4][2], const Unit& u, int wr, int wc, int fr, int fq) const {
#pragma unroll
        for (int ai = 0; ai < 2; ++ai)
#pragma unroll
            for (int m = 0; m < 4; ++m) { const int row = EPI_ROW(u, ai, m);
#pragma unroll
                for (int bj = 0; bj < 2; ++bj) { const int col = EPI_COL8(u, bj); f32x4 g0, g1; unpack8(*(const u32x4*)(P2 + (size_t)row * P2C + 1024 + col), g0, g1);
                    *(u32x4*)(M1 + (size_t)row * D + col) = pack8(acc[ai][bj][m][0] * g0, acc[ai][bj][m][1] * g1); } }
    }
};
struct EpiRet {
    static constexpr bool PERM = true, CHAIN = false;
    bf16_t* MRG; const bf16_t* M1; const bf16_t* P2;
    __device__ __forceinline__ void operator()(const f32x4 (&acc)[2][2][4][2], const Unit& u, int wr, int wc, int fr, int fq) const {
#pragma unroll
        for (int ai = 0; ai < 2; ++ai)
#pragma unroll
            for (int m = 0; m < 4; ++m) { const int row = EPI_ROW(u, ai, m);
#pragma unroll
                for (int bj = 0; bj < 2; ++bj) { const int col = EPI_COL8(u, bj); f32x4 g0, g1, a0, a1; unpack8(*(const u32x4*)(P2 + (size_t)row * P2C + 2048 + col), g0, g1);
                    unpack8(*(const u32x4*)(M1 + (size_t)row * D + col), a0, a1);
                    *(u32x4*)(MRG + (size_t)row * D + col) = pack8(a0 + acc[ai][bj][m][0] * g0, a1 + acc[ai][bj][m][1] * g1); } }
    }
};
struct EpiMerge {
    static constexpr bool PERM = true, CHAIN = true;
    bf16_t* MRG;
    __device__ __forceinline__ void operator()(f32x4 (&acc)[2][2][4][2], const Unit& u, int wr, int wc, int fr, int fq) const { const unsigned char* G8 = get_kp()->ws + WS_G8;
#pragma unroll
        for (int ai = 0; ai < 2; ++ai) { u32x2 rw[4][2];
#pragma unroll
            for (int m = 0; m < 4; ++m)
#pragma unroll
                for (int bj = 0; bj < 2; ++bj) rw[m][bj] = *(const u32x2*)(G8 + (size_t)EPI_ROW(u, ai, m) * 2048 + 1024 + EPI_COL8(u, bj));
            if (u.e == 0) { u32x2 hw[4][2];
#pragma unroll
                for (int m = 0; m < 4; ++m)
#pragma unroll
                    for (int bj = 0; bj < 2; ++bj) hw[m][bj] = *(const u32x2*)(G8 + (size_t)EPI_ROW(u, ai, m) * 2048 + EPI_COL8(u, bj));
#pragma unroll
                for (int m = 0; m < 4; ++m)
#pragma unroll
                    for (int bj = 0; bj < 2; ++bj) { const f32x4 r0 = unpk4_u8(rw[m][bj].x), r1 = unpk4_u8(rw[m][bj].y), h0 = unpk4_u8(hw[m][bj].x), h1 = unpk4_u8(hw[m][bj].y);
#pragma unroll
                        for (int j = 0; j < 4; ++j) { acc[ai][bj][m][0][j] *= h0[j] * __builtin_amdgcn_rcpf(r0[j]); acc[ai][bj][m][1][j] *= h1[j] * __builtin_amdgcn_rcpf(r1[j]); } }
            } else {
#pragma unroll
                for (int m = 0; m < 4; ++m)
#pragma unroll
                    for (int bj = 0; bj < 2; ++bj) *(u32x4*)(MRG + (size_t)EPI_ROW(u, ai, m) * D + EPI_COL8(u, bj)) = pack8(acc[ai][bj][m][0] * unpk4_u8(rw[m][bj].x), acc[ai][bj][m][1] * unpk4_u8(rw[m][bj].y));
            }
        }
    }
};
struct EpiOut {
    static constexpr bool PERM = true, CHAIN = false;
    bf16_t* X; const float* Xin32; const bf16_t* Xin16; const float* ga;
    __device__ __forceinline__ void operator()(const f32x4 (&acc)[2][2][4][2], const Unit& u, int wr, int wc, int fr, int fq) const {
        const int b = (u.pm * BM) >> 13;
        f32x4 g[2][2];
#pragma unroll
        for (int bj = 0; bj < 2; ++bj) { const int col = EPI_COL8(u, bj); g[bj][0] = *(const f32x4*)(ga + b * 6144 + col); g[bj][1] = *(const f32x4*)(ga + b * 6144 + col + 4); }
#pragma unroll
        for (int ai = 0; ai < 2; ++ai) {
            if (Xin32) { f32x4 x[4][2][2];
#pragma unroll
                for (int m = 0; m < 4; ++m)
#pragma unroll
                    for (int bj = 0; bj < 2; ++bj) { const float* xp = Xin32 + (size_t)EPI_ROW(u, ai, m) * D + EPI_COL8(u, bj); x[m][bj][0] = *(const f32x4*)xp; x[m][bj][1] = *(const f32x4*)(xp + 4); }
#pragma unroll
                for (int m = 0; m < 4; ++m)
#pragma unroll
                    for (int bj = 0; bj < 2; ++bj) *(u32x4*)(X + (size_t)EPI_ROW(u, ai, m) * D + EPI_COL8(u, bj)) = pack8(x[m][bj][0] + g[bj][0] * acc[ai][bj][m][0], x[m][bj][1] + g[bj][1] * acc[ai][bj][m][1]);
            } else { u32x4 xw[4][2];
#pragma unroll
                for (int m = 0; m < 4; ++m)
#pragma unroll
                    for (int bj = 0; bj < 2; ++bj) xw[m][bj] = *(const u32x4*)(Xin16 + (size_t)EPI_ROW(u, ai, m) * D + EPI_COL8(u, bj));
#pragma unroll
                for (int m = 0; m < 4; ++m)
#pragma unroll
                    for (int bj = 0; bj < 2; ++bj) { f32x4 x0, x1; unpack8(xw[m][bj], x0, x1);
                        *(u32x4*)(X + (size_t)EPI_ROW(u, ai, m) * D + EPI_COL8(u, bj)) = pack8(x0 + g[bj][0] * acc[ai][bj][m][0], x1 + g[bj][1] * acc[ai][bj][m][1]); }
            }
        }
    }
};
struct EpiGU {
    static constexpr bool PERM = true, CHAIN = false;
    bf16_t* ACT; const float* bias;
    __device__ __forceinline__ void operator()(const f32x4 (&acc)[2][2][4][2], const Unit& u, int wr, int wc, int fr, int fq) const {
        const float* be = bias + (size_t)u.e * 2048;
#pragma unroll
        for (int bj = 0; bj < 2; ++bj) { const int col = EPI_COL8(u, bj); const f32x4 b0 = *(const f32x4*)(be + col), b1 = *(const f32x4*)(be + col + 4);
#pragma unroll
            for (int ai = 0; ai < 2; ++ai)
#pragma unroll
                for (int m = 0; m < 4; ++m) { const int row = EPI_ROW(u, ai, m); const f32x4 v0 = acc[ai][bj][m][0] + b0, v1 = acc[ai][bj][m][1] + b1; float a[4];
#pragma unroll
                    for (int j = 0; j < 4; ++j) { const float gt = fminf(j < 2 ? v0[2 * j] : v1[2 * j - 4], 7.0f); float up = j < 2 ? v0[2 * j + 1] : v1[2 * j - 3]; up = fminf(fmaxf(up, -7.0f), 7.0f);
                        a[j] = (up + 1.0f) * (gt * sigmoidf_(1.702f * gt)); }
                    u32x2 w; w.x = cvt_pk_bf16(a[0], a[1]); w.y = cvt_pk_bf16(a[2], a[3]);
                    *(u32x2*)(ACT + (size_t)row * FF + (col >> 1)) = w; } }
    }
};
__device__ __forceinline__ unsigned pk4_fp8(float a, float b, float c, float d) { int w = 0; w = __builtin_amdgcn_cvt_pk_fp8_f32(a, b, w, false); w = __builtin_amdgcn_cvt_pk_fp8_f32(c, d, w, true); return (unsigned)w; }
struct EpiGU8 {
    static constexpr bool PERM = true, CHAIN = false;
    int l;
    __device__ __forceinline__ void operator()(const f32x4 (&acc)[2][2][4][2], const Unit& u, int wr, int wc, int fr, int fq) const {
        const KP kp_ = get_kp(); unsigned char* ACT8 = kp_->ws + WS_ACT; const float* bias = kp_->in[I_BGU] + (size_t)l * NE * 2048;
        const int f0 = u.pn * 128 + wc * 32 + 8 * fq; const float* be = bias + (size_t)u.e * 2048 + 2 * f0;
        const f32x4 q0 = *(const f32x4*)(be), q1 = *(const f32x4*)(be + 4), q2 = *(const f32x4*)(be + 8), q3 = *(const f32x4*)(be + 12);
        const float bg[8] = {q0[0], q0[2], q1[0], q1[2], q2[0], q2[2], q3[0], q3[2]}, bu[8] = {q0[1], q0[3], q1[1], q1[3], q2[1], q2[3], q3[1], q3[3]};
#pragma unroll
        for (int ai = 0; ai < 2; ++ai)
#pragma unroll
            for (int m = 0; m < 4; ++m) { const int row = EPI_ROW(u, ai, m); float a[8];
#pragma unroll
                for (int j = 0; j < 8; ++j) { const float gt = fminf(acc[ai][0][m][j >> 2][j & 3] * 0.03125f + bg[j], 7.0f); const float up = fminf(fmaxf(acc[ai][1][m][j >> 2][j & 3] * 0.03125f + bu[j], -7.0f), 7.0f);
                    a[j] = (up + 1.0f) * (gt * sigmoid_fast(1.702f * gt)); }
                u32x2 w; w.x = pk4_fp8(a[0], a[1], a[2], a[3]); w.y = pk4_fp8(a[4], a[5], a[6], a[7]);
                *(u32x2*)(ACT8 + (size_t)row * FF + f0) = w; }
    }
};
struct EpiDown {
    static constexpr bool PERM = true, CHAIN = false;
    int l; float sc;
    __device__ __forceinline__ void operator()(const f32x4 (&acc)[2][2][4][2], const Unit& u, int wr, int wc, int fr, int fq) const {
        const KP kp_ = get_kp(); bf16_t* YB = (bf16_t*)(kp_->ws + WS_YB); const float* bias = kp_->in[I_BDN] + (size_t)l * NE * D;
        const float* be = bias + (size_t)u.e * 1024; f32x4 bb[2][2];
#pragma unroll
        for (int bj = 0; bj < 2; ++bj) { bb[bj][0] = *(const f32x4*)(be + EPI_COL8(u, bj)); bb[bj][1] = *(const f32x4*)(be + EPI_COL8(u, bj) + 4); }
#pragma unroll
        for (int bj = 0; bj < 2; ++bj) { const int col = EPI_COL8(u, bj); const f32x4 b0 = bb[bj][0], b1 = bb[bj][1];
#pragma unroll
            for (int ai = 0; ai < 2; ++ai)
#pragma unroll
                for (int m = 0; m < 4; ++m) { const int row = EPI_ROW(u, ai, m);
                    { const f32x4 y0 = acc[ai][bj][m][0] * sc + b0, y1 = acc[ai][bj][m][1] * sc + b1; u32x2 w8; w8.x = pk4_fp8(y0[0], y0[1], y0[2], y0[3]); w8.y = pk4_fp8(y1[0], y1[1], y1[2], y1[3]);
                      *(u32x2*)((unsigned char*)YB + (size_t)row * D + col) = w8; } } }
    }
};
}
__device__ __forceinline__ void titem_load(f32x4 (&r)[8], const float* src, int N, int lane) {
#pragma unroll
    for (int i = 0; i < 8; ++i) r[i] = *(const f32x4*)(src + (size_t)(8 * i + (lane >> 3)) * N + (lane & 7) * 4);
}
__device__ __forceinline__ void titem_to_lds(const f32x4 (&r)[8], LAS float* scr, int lane) {
#pragma unroll
    for (int i = 0; i < 8; ++i) *(LAS f32x4*)(scr + (8 * i + (lane >> 3)) * 36 + (lane & 7) * 4) = r[i];
    LDS_WAIT(); asm volatile("" ::: "memory");
}
template <class RowPtr>
__device__ __forceinline__ void titem_store_bf16(LAS float* scr, int lane, int k0, int n0, const RowPtr& rp) {
    const int c = lane & 7;
#pragma unroll
    for (int j = 0; j < 4; ++j) { const int n = (lane >> 3) + 8 * j; const LAS float* s = scr + (8 * c) * 36 + n;
        u32x4 o; o.x = pk2(s[0 * 36], s[1 * 36]); o.y = pk2(s[2 * 36], s[3 * 36]); o.z = pk2(s[4 * 36], s[5 * 36]); o.w = pk2(s[6 * 36], s[7 * 36]);
        *(u32x4*)(rp(n0 + n) + k0 + 8 * c) = o; }
    LDS_WAIT(); asm volatile("" ::: "memory");
}
template <class RowPtr8>
__device__ __forceinline__ void titem_store_fp8(LAS float* scr, int lane, int k0, int n0, const RowPtr8& rp, float scale) {
#pragma unroll
    for (int j = 0; j < 2; ++j) { const int task = lane + 64 * j, n = task >> 2, kc = task & 3; const LAS float* s = scr + (16 * kc) * 36 + n; u32x4 o;
        o.x = pg8::pk4_fp8(s[0 * 36] * scale, s[1 * 36] * scale, s[2 * 36] * scale, s[3 * 36] * scale); o.y = pg8::pk4_fp8(s[4 * 36] * scale, s[5 * 36] * scale, s[6 * 36] * scale, s[7 * 36] * scale);
        o.z = pg8::pk4_fp8(s[8 * 36] * scale, s[9 * 36] * scale, s[10 * 36] * scale, s[11 * 36] * scale); o.w = pg8::pk4_fp8(s[12 * 36] * scale, s[13 * 36] * scale, s[14 * 36] * scale, s[15 * 36] * scale);
        *(u32x4*)(rp(n0 + n) + k0 + 16 * kc) = o; }
    LDS_WAIT(); asm volatile("" ::: "memory");
}
struct RowPlain8 { unsigned char* base; int K; __device__ __forceinline__ unsigned char* operator()(int n) const { return base + (size_t)n * K; } };
struct RowGU8 { unsigned char* base; __device__ __forceinline__ unsigned char* operator()(int n) const { const int f = n >> 1; return base + (size_t)((f >> 7) * 256 + (n & 1) * 128 + (f & 127)) * D; } };
struct RowPlain { bf16_t* base; int K; __device__ __forceinline__ bf16_t* operator()(int n) const { return base + (size_t)n * K; } };
struct RowIn8 { unsigned char* w1; unsigned char* w2;
    __device__ __forceinline__ unsigned char* operator()(int n) const {
        if (n < 1536) return w1 + (size_t)n * D;
        if (n < 2048) { const int j = n - 1536, qk = j >> 8, jj = j & 255, hh = jj >> 6, d = jj & 63, dn = d < 32 ? 2 * d : 2 * (d - 32) + 1; return w2 + (size_t)(qk * 256 + hh * 64 + dn) * D; }
        if (n < 2560) return w1 + (size_t)(1536 + n - 2048) * D;
        return w2 + (size_t)(512 + n - 2560) * D; } };

__device__ __forceinline__ void prologue_phase(const Ctx& c0) { PH_ENTER();
    unsigned char* ws = c.ws;
#ifdef PRO_REP_A
    for (int prep_ = 0, pn_ = [] { int n_ = PRO_REP_A; asm volatile("" : "+s"(n_)); return n_; }(); prep_ < pn_; ++prep_)
#endif
    {
        LAS float* scr = (LAS float*)(c.lds + c.wave * 16384);
        const int gw = c.vcu * 8 + c.wave, NGW = c.G * 8;
        constexpr int N_IN_ = DEPTH * 16 * 160, N_HY = DEPTH * 8 * 32, N_RET = N_HY, N_OUT = DEPTH * 16 * 32, N_GU = DEPTH * NE * 16 * 64, N_DN = DEPTH * NE * 16 * 32;
        constexpr int NITEMS = N_IN_ + N_HY + N_RET + N_OUT + N_GU + N_DN;
#define TITEM_DECODE(it_, kind_, mi_, kb_, nb_, src_, N_) do { int r_ = (it_); \
            if (r_ < N_IN_) { kind_ = 0; mi_ = r_ / 2560; const int q_ = r_ % 2560; kb_ = q_ / 160; nb_ = q_ % 160; N_ = INC; src_ = p->in[I_WIN] + (size_t)mi_ * D * INC; } \
            else if ((r_ -= N_IN_) < N_HY) { kind_ = 1; mi_ = r_ / 256; const int q_ = r_ % 256; kb_ = q_ / 32; nb_ = q_ % 32; N_ = D; src_ = p->in[I_WHY] + (size_t)mi_ * 512 * D; } \
            else if ((r_ -= N_HY) < N_RET) { kind_ = 2; mi_ = r_ / 256; const int q_ = r_ % 256; kb_ = q_ / 32; nb_ = q_ % 32; N_ = D; src_ = p->in[I_WRET] + (size_t)mi_ * 512 * D; } \
            else if ((r_ -= N_RET) < N_OUT) { kind_ = 3; mi_ = r_ / 512; const int q_ = r_ % 512; kb_ = q_ / 32; nb_ = q_ % 32; N_ = D; src_ = p->in[I_WOUT] + (size_t)mi_ * D * D; } \
            else if ((r_ -= N_OUT) < N_GU) { kind_ = 4; mi_ = r_ / 1024; const int q_ = r_ % 1024; kb_ = q_ / 64; nb_ = q_ % 64; N_ = 2048; src_ = p->in[I_WGU] + (size_t)mi_ * D * 2048; } \
            else { r_ -= N_GU; kind_ = 5; mi_ = r_ / 512; const int q_ = r_ % 512; kb_ = q_ / 32; nb_ = q_ % 32; N_ = D; src_ = p->in[I_WDN] + (size_t)mi_ * FF * D; } \
            src_ += (size_t)(kb_ * 64) * N_ + nb_ * 32; } while (0)
        f32x4 cur[8], nxt[8]; int kind = 0, mi = 0, kb = 0, nb = 0, N = 0; const float* src = nullptr;
        if (gw < NITEMS) { TITEM_DECODE(gw, kind, mi, kb, nb, src, N); titem_load(cur, src, N, c.lane); }
        for (int it = gw; it < NITEMS; it += NGW) {
            int kind2 = 0, mi2 = 0, kb2 = 0, nb2 = 0, N2 = 0; const float* src2 = nullptr; const bool more = it + NGW < NITEMS;
            if (more) { TITEM_DECODE(it + NGW, kind2, mi2, kb2, nb2, src2, N2); titem_load(nxt, src2, N2, c.lane); }
            titem_to_lds(cur, scr, c.lane);
            const int k0 = kb * 64, n0 = nb * 32;
            if (kind == 0) { RowIn8 rp{ws + WS_WIN1 + (size_t)mi * P1R * D, ws + WS_WIN2 + (size_t)mi * P2C * D}; titem_store_fp8(scr, c.lane, k0, n0, rp, 32.0f); }
            else if (kind == 1) { RowPlain rp{(bf16_t*)(ws + WS_WHY) + (size_t)mi * D * 512, 512}; titem_store_bf16(scr, c.lane, k0, n0, rp); }
            else if (kind == 2) { RowPlain rp{(bf16_t*)(ws + WS_WRET) + (size_t)mi * D * 512, 512}; titem_store_bf16(scr, c.lane, k0, n0, rp); }
            else if (kind == 3) { RowPlain rp{(bf16_t*)(ws + WS_WOUT) + (size_t)mi * D * D, D}; titem_store_bf16(scr, c.lane, k0, n0, rp); }
            else if (kind == 4) { RowGU8 rp{ws + WS_WGU + (size_t)mi * 2048 * D}; titem_store_fp8(scr, c.lane, k0, n0, rp, 32.0f); }
            else { RowPlain8 rp{ws + WS_WDN + (size_t)mi * D * FF, FF}; titem_store_fp8(scr, c.lane, k0, n0, rp, 32.0f); }
            if (more) {
#pragma unroll
                for (int i = 0; i < 8; ++i) cur[i] = nxt[i];
                kind = kind2; mi = mi2; kb = kb2; nb = nb2; }
        }
#undef TITEM_DECODE
    }
    __syncthreads();
    {
        float* rope = (float*)(ws + WS_ROPE);
        for (int idx = c.vcu * NT + c.tid; idx < S * 32; idx += c.G * NT) { const int pos = idx >> 5, i = idx & 31;
            const float inv = 1.0f / powf(10000.0f, (float)(2 * i) / 64.0f); const float ang = (float)pos * inv;
            rope[2 * idx] = cosf(ang); rope[2 * idx + 1] = sinf(ang); }
    }
#ifdef PRO_REP_C
    for (int prep_ = 0, pn_ = [] { int n_ = PRO_REP_C; asm volatile("" : "+s"(n_)); return n_; }(); prep_ < pn_; ++prep_)
#endif
    {
        LAS float* ca = (LAS float*)c.lds;
        LAS float* red = (LAS float*)(c.lds + 16384);
        for (int i = c.tid; i < NB * D; i += NT) { const float v = p->in[I_C][i]; ca[i] = v / (1.0f + __expf(-v)); }
        __syncthreads();
        float* mod = (float*)(ws + WS_MOD);
        for (int it = c.vcu; it < DEPTH * 96; it += c.G) { const int l = it / 96, nb = it % 96, n = nb * 64 + c.lane;
            const float* w = p->in[I_WMOD] + (size_t)l * D * 6144 + n; float a0 = 0.f, a1 = 0.f, a2 = 0.f, a3 = 0.f;
            const int kb = c.wave * 128;
#pragma unroll 8
            for (int k = 0; k < 128; ++k) { const float wv = w[(size_t)(kb + k) * 6144]; a0 += ca[kb + k] * wv; a1 += ca[1024 + kb + k] * wv; a2 += ca[2048 + kb + k] * wv; a3 += ca[3072 + kb + k] * wv; }
            red[(c.wave * 4 + 0) * 64 + c.lane] = a0; red[(c.wave * 4 + 1) * 64 + c.lane] = a1; red[(c.wave * 4 + 2) * 64 + c.lane] = a2; red[(c.wave * 4 + 3) * 64 + c.lane] = a3;
            __syncthreads();
            if (c.tid < 256) { const int b = c.tid >> 6, ln = c.tid & 63; float s = 0.f;
#pragma unroll
                for (int w8 = 0; w8 < 8; ++w8) s += red[(w8 * 4 + b) * 64 + ln];
                mod[(size_t)(l * NB + b) * 6144 + nb * 64 + ln] = s + p->in[I_BMOD][l * 6144 + nb * 64 + ln]; }
            __syncthreads();
        }
    }
}
__device__ __forceinline__ void expert_tile_prefix(const unsigned* cnt, LAS int* tab, int tid) {
    if (tid < 32) tab[32 + tid] = (int)__hip_atomic_load(cnt + tid, __ATOMIC_RELAXED, __HIP_MEMORY_SCOPE_AGENT);
    __syncthreads();
    if (tid < 32) { int pre = 0;
        for (int q = 0; q < tid; ++q) pre += (tab[32 + q] + 255) >> 8;
        tab[tid] = pre * 256; if (tid == 31) tab[64] = pre + ((tab[63] + 255) >> 8); }
}

template <int MODE>
__device__ __forceinline__ void norm_phase(const Ctx& c0, int l, const int dry = 0) { PH_ENTER();
    unsigned char* ws = c.ws;
    LAS float* wrT = (LAS float*)c.lds;
    LAS int* tab = (LAS int*)(c.lds + LDS_TAB);
    LAS int* lcount = tab + 128;
    LAS int* lbase = tab + 160;
    LAS int* asg_e = tab + 256;
    LAS int* asg_r = tab + 768;
    unsigned* counts = (unsigned*)(ws + WS_CTL) + CW_CNT;
    bf16_t* X = (bf16_t*)(ws + WS_X); bf16_t* H = (bf16_t*)(ws + WS_H);
    const float* mod = (const float*)(ws + WS_MOD);
    int* tok_e = (int*)(ws + WS_TOKE); float* tok_g = (float*)(ws + WS_TOKG); int* tok_p = (int*)(ws + WS_TOKP); int* slot_tok = (int*)(ws + WS_SLOT);
    const bf16_t* YB = (const bf16_t*)(ws + WS_YB);
    const int lp = (MODE == 3) ? DEPTH - 1 : l - 1;
    if (MODE == 1 || MODE == 3) expert_tile_prefix(counts + lp * 32, tab, c.tid);
    if (MODE == 2) { const float* wr = p->in[I_WR] + (size_t)l * D * NE;
        for (int idx = c.tid; idx < D * NE; idx += NT) { const int cc = idx >> 5, e = idx & 31; wrT[e * D + cc] = wr[idx]; } }
    __syncthreads();
    const float* gvec = (MODE == 3) ? p->in[I_FG] : (MODE == 2 ? p->in[I_NFG] + l * D : p->in[I_NMG] + l * D);
    for (int blk = c.vcu; blk < T / 128; blk += c.G) {
        if (MODE == 2) { if (c.tid < 32) lcount[c.tid] = 0; __syncthreads(); }
        for (int r = 0; r < 16; ++r) {
            const int tl = c.wave * 16 + r, t = blk * 128 + tl, b = t >> 13;
            f32x4 v[4];
#pragma unroll
            for (int j = 0; j < 4; ++j) v[j] = (MODE == 0) ? *(const f32x4*)(p->in[I_X] + (size_t)t * D + 4 * c.lane + 256 * j) : bf4_to_f32(*(const u32x2*)(X + (size_t)t * D + 4 * c.lane + 256 * j));
            if (MODE == 1 || MODE == 3) {
                const float* gaf = mod + (size_t)(lp * NB + b) * 6144 + 5 * 1024;
                f32x4 s[4] = {{0.f, 0.f, 0.f, 0.f}, {0.f, 0.f, 0.f, 0.f}, {0.f, 0.f, 0.f, 0.f}, {0.f, 0.f, 0.f, 0.f}};
#pragma unroll
                for (int k = 0; k < 4; ++k) { const int e = tok_e[t * 4 + k], ps = tok_p[t * 4 + k]; const float gk = tok_g[t * 4 + k];
#pragma unroll
                    for (int j = 0; j < 4; ++j) { const int w = *(const int*)((const unsigned char*)YB + (size_t)(tab[e] + ps) * D + 4 * c.lane + 256 * j);
                        s[j] += gk * (f32x4){__builtin_amdgcn_cvt_f32_fp8(w, 0), __builtin_amdgcn_cvt_f32_fp8(w, 1), __builtin_amdgcn_cvt_f32_fp8(w, 2), __builtin_amdgcn_cvt_f32_fp8(w, 3)}; } }
#pragma unroll
                for (int j = 0; j < 4; ++j) { const f32x4 g = *(const f32x4*)(gaf + 4 * c.lane + 256 * j); v[j] += g * s[j]; if (MODE == 1 && !dry) { u32x2 w; w.x = pk2(v[j].x, v[j].y); w.y = pk2(v[j].z, v[j].w); *(u32x2*)(X + (size_t)t * D + 4 * c.lane + 256 * j) = w; } }
            }
            float ss = 0.f;
#pragma unroll
            for (int j = 0; j < 4; ++j) ss += (v[j].x * v[j].x + v[j].y * v[j].y) + (v[j].z * v[j].z + v[j].w * v[j].w);
            const float rstd = __builtin_amdgcn_rsqf(wave_sum(ss, c.lane) * (1.0f / D) + EPS);
            if (MODE == 3) {
#pragma unroll
                for (int j = 0; j < 4; ++j) { const f32x4 g = *(const f32x4*)(gvec + 4 * c.lane + 256 * j); *(f32x4*)(p->out + (size_t)t * D + 4 * c.lane + 256 * j) = v[j] * rstd * g; }
                continue;
            }
            const float* mrow = mod + (size_t)(l * NB + b) * 6144 + (MODE == 2 ? 3 * 1024 : 0);
#pragma unroll
            for (int j = 0; j < 4; ++j) { const int cc = 4 * c.lane + 256 * j; const f32x4 g = *(const f32x4*)(gvec + cc), sh = *(const f32x4*)(mrow + cc), sc = *(const f32x4*)(mrow + 1024 + cc);
                v[j] = (v[j] * rstd * g) * (1.0f + sc) + sh;
                { *(unsigned*)(ws + WS_H8A + (size_t)t * D + cc) = pg8::pk4_fp8(v[j].x, v[j].y, v[j].z, v[j].w); } }
            if (MODE == 2) {
                float mylg = -3.0e38f;
#pragma unroll 2
                for (int e = 0; e < 32; ++e) { float s = 0.f;
#pragma unroll
                    for (int j = 0; j < 4; ++j) { const f32x4 w = *(const LAS f32x4*)(wrT + e * D + 4 * c.lane + 256 * j); s += (v[j].x * w.x + v[j].y * w.y) + (v[j].z * w.z + v[j].w * w.w); }
                    const float tot = wave_sum(s, c.lane) + p->in[I_BR][l * NE + e]; mylg = (c.lane == e) ? tot : mylg; }
                int idx[4]; float val[4];
#pragma unroll
                for (int k = 0; k < 4; ++k) { float bv = mylg; int bi = c.lane;
#define TOP_STEP(OV, OI) do { const float ov = (OV); const int oi = (OI); const bool take = (ov > bv) || (ov == bv && oi < bi); bv = take ? ov : bv; bi = take ? oi : bi; } while (0)
                    TOP_STEP(swz_xor<1>(bv), swz_xor_i<1>(bi)); TOP_STEP(swz_xor<2>(bv), swz_xor_i<2>(bi)); TOP_STEP(swz_xor<4>(bv), swz_xor_i<4>(bi)); TOP_STEP(swz_xor<8>(bv), swz_xor_i<8>(bi));
                    TOP_STEP(swz_xor<16>(bv), swz_xor_i<16>(bi)); TOP_STEP(xor32(bv, c.lane), xor32_i(bi, c.lane));
#undef TOP_STEP
                    idx[k] = bi; val[k] = bv; mylg = (c.lane == bi) ? -3.0e38f : mylg; }
                const float e1 = __expf(val[1] - val[0]), e2 = __expf(val[2] - val[0]), e3 = __expf(val[3] - val[0]); const float inv = 1.0f / (1.0f + e1 + e2 + e3);
                if (c.lane < 4) { const int k = c.lane; const int e = k == 0 ? idx[0] : (k == 1 ? idx[1] : (k == 2 ? idx[2] : idx[3])); const float gk = (k == 0 ? 1.0f : (k == 1 ? e1 : (k == 2 ? e2 : e3))) * inv;
                    const int rk = __hip_atomic_fetch_add(lcount + e, 1, __ATOMIC_RELAXED, __HIP_MEMORY_SCOPE_WORKGROUP);
                    asg_e[tl * 4 + k] = e; asg_r[tl * 4 + k] = rk; tok_e[t * 4 + k] = e; tok_g[t * 4 + k] = gk; }
            }
        }
        if (MODE == 2) {
            __syncthreads();
            if (c.tid < 32) lbase[c.tid] = dry ? 0 : (int)__hip_atomic_fetch_add(counts + l * 32 + c.tid, (unsigned)lcount[c.tid], __ATOMIC_RELAXED, __HIP_MEMORY_SCOPE_AGENT);
            __syncthreads();
            { const int a = c.tid, e = asg_e[a], ps = lbase[e] + asg_r[a], t = blk * 128 + (a >> 2); if (!dry) { tok_p[t * 4 + (a & 3)] = ps; slot_tok[e * CAP + ps] = t; } }
            __syncthreads();
        }
    }
}

__device__ __forceinline__ float reduce32(float (&s)[32], int lane) {
    const bool h5 = (lane & 32) != 0, h4 = (lane & 16) != 0, h3 = (lane & 8) != 0, h2 = (lane & 4) != 0, h1 = (lane & 2) != 0;
#pragma unroll
    for (int i = 0; i < 16; ++i) { const float keep = h5 ? s[i + 16] : s[i], send = h5 ? s[i] : s[i + 16]; s[i] = keep + xor32(send, lane); }
#pragma unroll
    for (int i = 0; i < 8; ++i) { const float keep = h4 ? s[i + 8] : s[i], send = h4 ? s[i] : s[i + 8]; s[i] = keep + swz_xor<16>(send); }
#pragma unroll
    for (int i = 0; i < 4; ++i) { const float keep = h3 ? s[i + 4] : s[i], send = h3 ? s[i] : s[i + 4]; s[i] = keep + swz_xor<8>(send); }
#pragma unroll
    for (int i = 0; i < 2; ++i) { const float keep = h2 ? s[i + 2] : s[i], send = h2 ? s[i] : s[i + 2]; s[i] = keep + swz_xor<4>(send); }
    { const float keep = h1 ? s[1] : s[0], send = h1 ? s[0] : s[1]; s[0] = keep + swz_xor<2>(send); }
    return s[0] + swz_xor<1>(s[0]);
}
__device__ __forceinline__ void top4_lanes(float mylg, const int elane, const int lane, int (&idx)[4], float (&val)[4]) {
#pragma unroll
    for (int k = 0; k < 4; ++k) { float bv = mylg; int bi = elane;
#define TOP_STEP(OV, OI) do { const float ov = (OV); const int oi = (OI); const bool take = (ov > bv) || (ov == bv && oi < bi); bv = take ? ov : bv; bi = take ? oi : bi; } while (0)
        TOP_STEP(swz_xor<2>(bv), swz_xor_i<2>(bi)); TOP_STEP(swz_xor<4>(bv), swz_xor_i<4>(bi)); TOP_STEP(swz_xor<8>(bv), swz_xor_i<8>(bi)); TOP_STEP(swz_xor<16>(bv), swz_xor_i<16>(bi)); TOP_STEP(xor32(bv, lane), xor32_i(bi, lane));
#undef TOP_STEP
        idx[k] = bi; val[k] = bv; mylg = (elane == bi) ? -3.0e38f : mylg; }
}
constexpr int NF_XS = 2064;
__device__ __forceinline__ void normf_phase(const Ctx& c0, int l, const int dry = 0) { PH_ENTER();
    unsigned char* ws = c.ws;
    LAS unsigned char* XH = c.lds; LAS unsigned char* XL = c.lds + 16 * NF_XS; LAS float* PART = (LAS float*)(c.lds + 32 * NF_XS);
    LAS int* tab = (LAS int*)(c.lds + 32 * NF_XS + 16384); LAS int* lcount = tab; LAS int* lbase = tab + 32; LAS int* asg_e = tab + 64; LAS int* asg_r = tab + 576;
    unsigned* counts = (unsigned*)(ws + WS_CTL) + CW_CNT;
    const bf16_t* X = (const bf16_t*)(ws + WS_X); unsigned char* H8 = ws + WS_H; const float* mod = (const float*)(ws + WS_MOD);
    int* tok_e = (int*)(ws + WS_TOKE); float* tok_g = (float*)(ws + WS_TOKG); int* tok_p = (int*)(ws + WS_TOKP); int* slot_tok = (int*)(ws + WS_SLOT);
    const int fr = c.lane & 15, fq = c.lane >> 4;
    bf16x8 yh[2][4], yl[2][4];
    { const float* wr = p->in[I_WR] + (size_t)l * D * NE;
#pragma unroll
      for (int ct = 0; ct < 2; ++ct)
#pragma unroll
        for (int ks = 0; ks < 4; ++ks) { unsigned hw[4], lw[4];
#pragma unroll
            for (int i2 = 0; i2 < 4; ++i2) { const float a = wr[(size_t)(128 * c.wave + 32 * ks + 8 * fq + 2 * i2) * NE + 16 * ct + fr], b_ = wr[(size_t)(128 * c.wave + 32 * ks + 8 * fq + 2 * i2 + 1) * NE + 16 * ct + fr];
                hw[i2] = pk2(a, b_); lw[i2] = pk2(a - bf_lo(hw[i2]), b_ - bf_hi(hw[i2])); }
            yh[ct][ks] = __builtin_bit_cast(bf16x8, (u32x4){hw[0], hw[1], hw[2], hw[3]}); yl[ct][ks] = __builtin_bit_cast(bf16x8, (u32x4){lw[0], lw[1], lw[2], lw[3]}); } }
    const float* gvec = p->in[I_NFG] + l * D; const float brl = p->in[I_BR][l * NE + (c.lane & 31)];
    for (int blk = c.vcu; blk < T / 128; blk += c.G) {
        __syncthreads();
        if (c.tid < 32) lcount[c.tid] = 0;
        const int b = (blk * 128) >> 13; const float* mrow = mod + (size_t)(l * NB + b) * 6144 + 3 * 1024;
        u32x2 n0[4], n1[4];
        { const int t = blk * 128 + 2 * c.wave;
#pragma unroll
          for (int j = 0; j < 4; ++j) { n0[j] = *(const u32x2*)(X + (size_t)t * D + 4 * c.lane + 256 * j); n1[j] = *(const u32x2*)(X + (size_t)(t + 1) * D + 4 * c.lane + 256 * j); } }
        for (int tile = 0; tile < 8; ++tile) {
            const int t = blk * 128 + tile * 16 + 2 * c.wave;
            f32x4 v0[4], v1[4];
#pragma unroll
            for (int j = 0; j < 4; ++j) { v0[j] = bf4_to_f32(n0[j]); v1[j] = bf4_to_f32(n1[j]); }
            if (tile < 7) {
#pragma unroll
                for (int j = 0; j < 4; ++j) { n0[j] = *(const u32x2*)(X + (size_t)(t + 16) * D + 4 * c.lane + 256 * j); n1[j] = *(const u32x2*)(X + (size_t)(t + 17) * D + 4 * c.lane + 256 * j); } }
            float ss0 = 0.f, ss1 = 0.f;
#pragma unroll
            for (int j = 0; j < 4; ++j) { ss0 += (v0[j].x * v0[j].x + v0[j].y * v0[j].y) + (v0[j].z * v0[j].z + v0[j].w * v0[j].w); ss1 += (v1[j].x * v1[j].x + v1[j].y * v1[j].y) + (v1[j].z * v1[j].z + v1[j].w * v1[j].w); }
            const float rs0 = __builtin_amdgcn_rsqf(wave_sum(ss0, c.lane) * (1.0f / D) + EPS), rs1 = __builtin_amdgcn_rsqf(wave_sum(ss1, c.lane) * (1.0f / D) + EPS);
#pragma unroll
            for (int j = 0; j < 4; ++j) { const int cc = 4 * c.lane + 256 * j; const f32x4 g = *(const f32x4*)(gvec + cc), sh = *(const f32x4*)(mrow + cc), sc = *(const f32x4*)(mrow + 1024 + cc);
                v0[j] = (v0[j] * rs0 * g) * (1.0f + sc) + sh; v1[j] = (v1[j] * rs1 * g) * (1.0f + sc) + sh;
                *(unsigned*)(H8 + (size_t)t * D + cc) = pg8::pk4_fp8(v0[j].x, v0[j].y, v0[j].z, v0[j].w); *(unsigned*)(H8 + (size_t)(t + 1) * D + cc) = pg8::pk4_fp8(v1[j].x, v1[j].y, v1[j].z, v1[j].w);
                u32x2 h0, l0, h1, l1;
                h0.x = pk2(v0[j].x, v0[j].y); h0.y = pk2(v0[j].z, v0[j].w); l0.x = pk2(v0[j].x - bf_lo(h0.x), v0[j].y - bf_hi(h0.x)); l0.y = pk2(v0[j].z - bf_lo(h0.y), v0[j].w - bf_hi(h0.y));
                h1.x = pk2(v1[j].x, v1[j].y); h1.y = pk2(v1[j].z, v1[j].w); l1.x = pk2(v1[j].x - bf_lo(h1.x), v1[j].y - bf_hi(h1.x)); l1.y = pk2(v1[j].z - bf_lo(h1.y), v1[j].w - bf_hi(h1.y));
                *(LAS u32x2*)(XH + (2 * c.wave) * NF_XS + cc * 2) = h0; *(LAS u32x2*)(XL + (2 * c.wave) * NF_XS + cc * 2) = l0;
                *(LAS u32x2*)(XH + (2 * c.wave + 1) * NF_XS + cc * 2) = h1; *(LAS u32x2*)(XL + (2 * c.wave + 1) * NF_XS + cc * 2) = l1; }
            __syncthreads();
            { f32x4 a0 = {0.f, 0.f, 0.f, 0.f}, a1 = {0.f, 0.f, 0.f, 0.f};
#pragma unroll
              for (int ks = 0; ks < 4; ++ks) { const int kel = 128 * c.wave + 32 * ks + 8 * fq;
                  const bf16x8 xh = *(const LAS bf16x8*)(XH + fr * NF_XS + kel * 2), xl = *(const LAS bf16x8*)(XL + fr * NF_XS + kel * 2);
                  a0 = __builtin_amdgcn_mfma_f32_16x16x32_bf16(xh, yh[0][ks], a0, 0, 0, 0); a0 = __builtin_amdgcn_mfma_f32_16x16x32_bf16(xl, yh[0][ks], a0, 0, 0, 0); a0 = __builtin_amdgcn_mfma_f32_16x16x32_bf16(xh, yl[0][ks], a0, 0, 0, 0);
                  a1 = __builtin_amdgcn_mfma_f32_16x16x32_bf16(xh, yh[1][ks], a1, 0, 0, 0); a1 = __builtin_amdgcn_mfma_f32_16x16x32_bf16(xl, yh[1][ks], a1, 0, 0, 0); a1 = __builtin_amdgcn_mfma_f32_16x16x32_bf16(xh, yl[1][ks], a1, 0, 0, 0); }
#pragma unroll
              for (int r = 0; r < 4; ++r) { PART[(c.wave * 16 + 4 * fq + r) * 32 + fr] = a0[r]; PART[(c.wave * 16 + 4 * fq + r) * 32 + 16 + fr] = a1[r]; } }
            __syncthreads();
            { const int tok = 2 * c.wave + (c.lane >> 5), e = c.lane & 31; float lg = brl;
#pragma unroll
              for (int w8 = 0; w8 < 8; ++w8) lg += PART[(w8 * 16 + tok) * 32 + e];
              int idx[4]; float val[4]; float mylg = lg;
#pragma unroll
              for (int k = 0; k < 4; ++k) { float bv = mylg; int bi = e;
#define TOP_STEP(OV, OI) do { const float ov = (OV); const int oi = (OI); const bool take = (ov > bv) || (ov == bv && oi < bi); bv = take ? ov : bv; bi = take ? oi : bi; } while (0)
                  TOP_STEP(dpp_f<DPP_X1>(bv), dpp_i<DPP_X1>(bi)); TOP_STEP(dpp_f<DPP_X2>(bv), dpp_i<DPP_X2>(bi)); TOP_STEP(dpp_f<DPP_HM>(bv), dpp_i<DPP_HM>(bi)); TOP_STEP(dpp_f<DPP_RM>(bv), dpp_i<DPP_RM>(bi)); TOP_STEP(swz_xor<16>(bv), swz_xor_i<16>(bi));
#undef TOP_STEP
                  idx[k] = bi; val[k] = bv; mylg = (e == bi) ? -3.0e38f : mylg; }
              if (e < 4) { const int k = e; const int ek = k == 0 ? idx[0] : (k == 1 ? idx[1] : (k == 2 ? idx[2] : idx[3])); const float vk = k == 0 ? val[0] : (k == 1 ? val[1] : (k == 2 ? val[2] : val[3]));
                  const float gk = __expf(vk - val[0]) / (1.0f + __expf(val[1] - val[0]) + __expf(val[2] - val[0]) + __expf(val[3] - val[0]));
                  const int tl = tile * 16 + tok, tt = blk * 128 + tl;
                  const int rk = __hip_atomic_fetch_add(lcount + ek, 1, __ATOMIC_RELAXED, __HIP_MEMORY_SCOPE_WORKGROUP);
                  asg_e[tl * 4 + k] = ek; asg_r[tl * 4 + k] = rk; tok_e[tt * 4 + k] = ek; tok_g[tt * 4 + k] = gk; } }
        }
        __syncthreads();
        if (c.tid < 32) lbase[c.tid] = dry ? 0 : (int)__hip_atomic_fetch_add(counts + l * 32 + c.tid, (unsigned)lcount[c.tid], __ATOMIC_RELAXED, __HIP_MEMORY_SCOPE_AGENT);
        __syncthreads();
        { const int a = c.tid, e = asg_e[a], ps = lbase[e] + asg_r[a], t = blk * 128 + (a >> 2); if (!dry) { tok_p[t * 4 + (a & 3)] = ps; slot_tok[e * CAP + ps] = t; } }
    }
}

__device__ __forceinline__ void transpose_yhy_phase(const Ctx& c0) { PH_ENTER(); (void)p;
    const bf16_t* src = (const bf16_t*)(c.ws + WS_YHYT); bf16_t* dst = (bf16_t*)(c.ws + WS_YHY);
    LAS bf16_t* tile = (LAS bf16_t*)(c.lds + c.wave * 16384);
    const int gw = c.vcu * 8 + c.wave, NGW = c.G * 8, r8 = c.lane >> 3, q8 = c.lane & 7;
    u32x4 v[8];
    if (gw < 8 * (T / 64)) {
#pragma unroll
        for (int i = 0; i < 8; ++i) v[i] = *(const u32x4*)(src + (size_t)((gw & 7) * 64 + i * 8 + r8) * T + (gw >> 3) * 64 + q8 * 8);
    }
    for (int it = gw; it < 8 * (T / 64); it += NGW) { const int cb = it & 7, tb = it >> 3, ch0 = cb * 64, t0 = tb * 64;
#pragma unroll
        for (int i = 0; i < 8; ++i) { LAS unsigned* wp = (LAS unsigned*)(tile + (i * 8 + r8) * 66 + q8 * 8); wp[0] = v[i].x; wp[1] = v[i].y; wp[2] = v[i].z; wp[3] = v[i].w; }
        const int nx = it + NGW;
        if (nx < 8 * (T / 64)) {
#pragma unroll
            for (int i = 0; i < 8; ++i) v[i] = *(const u32x4*)(src + (size_t)((nx & 7) * 64 + i * 8 + r8) * T + (nx >> 3) * 64 + q8 * 8);
        }
        LDS_WAIT(); asm volatile("" ::: "memory");
#pragma unroll
        for (int i = 0; i < 8; ++i) { const int tt = i * 8 + r8; unsigned w[4];
#pragma unroll
            for (int k = 0; k < 4; ++k) w[k] = (unsigned)tile[(q8 * 8 + 2 * k) * 66 + tt] | ((unsigned)tile[(q8 * 8 + 2 * k + 1) * 66 + tt] << 16);
            *(u32x4*)(dst + (size_t)(t0 + tt) * 512 + ch0 + q8 * 8) = (u32x4){w[0], w[1], w[2], w[3]}; }
        LDS_WAIT(); asm volatile("" ::: "memory");
    }
}
__device__ __forceinline__ float block_sum512(float v, LAS float* red, int tid) {
    v = wave_sum(v, tid & 63); __syncthreads(); if ((tid & 63) == 0) red[tid >> 6] = v; __syncthreads();
    float s = 0.f;
#pragma unroll
    for (int i = 0; i < 8; ++i) s += red[i];
    return s;
}
__device__ __forceinline__ float shortconv_at(const bf16_t* row, int t, float w0, float w1, float w2, float bb) {
    const float xm = t > 0 ? bf2f(row[t - 1]) : 0.f, x0 = bf2f(row[t]), xp = t < S - 1 ? bf2f(row[t + 1]) : 0.f;
    return xm * w0 + x0 * w1 + xp * w2 + bb;
}
#ifndef FD
#define FD __device__ __forceinline__
#endif
#ifndef LASQ
#define LASQ LAS
#endif
#if defined(__HIP__)
#define FFT_SCHED() __builtin_amdgcn_sched_barrier(0)
typedef float cf __attribute__((ext_vector_type(2)));
FD cf fld_(const LASQ cf* b, int i) { return b[i]; }
FD void fst_(LASQ cf* b, int i, cf v) { b[i] = v; }
FD cf cadd(cf a, cf b) { return a + b; }
FD cf csub(cf a, cf b) { return a - b; }
FD cf cmul(cf a, cf b) { cf t, r;
    asm("v_pk_mul_f32 %0, %1, %2 op_sel_hi:[0,1]" : "=v"(t) : "v"(a), "v"(b));
    asm("v_pk_fma_f32 %0, %1, %2, %3 op_sel:[1,1,0] op_sel_hi:[1,0,1] neg_lo:[0,1,0]" : "=v"(r) : "v"(a), "v"(b), "v"(t));
    return r; }
FD cf cmulc(cf a, cf b) { cf t, r;
    asm("v_pk_mul_f32 %0, %1, %2 op_sel_hi:[1,0]" : "=v"(t) : "v"(a), "v"(b));
    asm("v_pk_fma_f32 %0, %1, %2, %3 op_sel:[1,1,0] op_sel_hi:[0,1,1] neg_hi:[1,0,0]" : "=v"(r) : "v"(a), "v"(b), "v"(t));
    return r; }
#else
#define FFT_SCHED()
struct cf { float x, y; };
FD cf fld_(const LASQ cf* b, int i) { return b[i]; }
FD void fst_(LASQ cf* b, int i, cf v) { b[i] = v; }
FD cf cadd(cf a, cf b) { return cf{a.x + b.x, a.y + b.y}; }
FD cf csub(cf a, cf b) { return cf{a.x - b.x, a.y - b.y}; }
FD cf cmul(cf a, cf b) { return cf{a.x * b.x - a.y * b.y, a.x * b.y + a.y * b.x}; }
FD cf cmulc(cf a, cf b) { return cf{a.x * b.x + a.y * b.y, a.y * b.x - a.x * b.y}; }
#endif
struct FftK { float c1, c2, c3, h, c5, c6, c7; };
FD FftK fft_consts() {
    FftK k{0.98078528040323043f, 0.92387953251128674f, 0.83146961230254524f, 0.70710678118654752f, 0.55557023301960218f, 0.38268343236508977f, 0.19509032201612825f};
#if defined(__HIP__)
    asm volatile("" : "+s"(k.c1), "+s"(k.c2), "+s"(k.c3), "+s"(k.h), "+s"(k.c5), "+s"(k.c6), "+s"(k.c7));
#endif
    return k;
}
FD cf mulw32(cf v, int k, bool inv, const FftK& K) {
    const float h = K.h;
    if (k == 0) return v;
#if defined(__HIP__)
    const float sg = inv ? -1.0f : 1.0f;
    if (k == 8) return v.yx * cf{sg, -sg};
    if (k == 4) return v * h + v.yx * cf{sg * h, -sg * h};
    if (k == 12) return v * -h + v.yx * cf{sg * h, -sg * h};
#else
    const cf rv = inv ? cf{-v.y, v.x} : cf{v.y, -v.x};
    if (k == 8) return rv;
    if (k == 4) return cf{(v.x + rv.x) * h, (v.y + rv.y) * h};
    if (k == 12) return cf{(rv.x - v.x) * h, (rv.y - v.y) * h};
#endif
    const float co = k == 1 ? K.c1 : k == 2 ? K.c2 : k == 3 ? K.c3 : k == 5 ? K.c5 : k == 6 ? K.c6 : k == 7 ? K.c7 : k == 9 ? -K.c7 : k == 10 ? -K.c6 : k == 11 ? -K.c5 : k == 13 ? -K.c3 : k == 14 ? -K.c2 : -K.c1;
    const float si = k == 1 ? K.c7 : k == 2 ? K.c6 : k == 3 ? K.c5 : k == 5 ? K.c3 : k == 6 ? K.c2 : k == 7 ? K.c1 : k == 9 ? K.c1 : k == 10 ? K.c2 : k == 11 ? K.c3 : k == 13 ? K.c5 : k == 14 ? K.c6 : K.c7;
#if defined(__HIP__)
    return v * co + v.yx * cf{sg * si, -sg * si};
#else
    return cf{v.x * co + rv.x * si, v.y * co + rv.y * si};
#endif
}
#if defined(__HIP__)
FD cf add_mi(cf u, cf x) { cf r; asm("v_pk_add_f32 %0, %1, %2 op_sel:[0,1] op_sel_hi:[1,0] neg_hi:[0,1]" : "=v"(r) : "v"(u), "v"(x)); return r; }
FD cf add_pi(cf u, cf x) { cf r; asm("v_pk_add_f32 %0, %1, %2 op_sel:[0,1] op_sel_hi:[1,0] neg_lo:[0,1]" : "=v"(r) : "v"(u), "v"(x)); return r; }
#else
FD cf add_mi(cf u, cf x) { return cf{u.x + x.y, u.y - x.x}; }
FD cf add_pi(cf u, cf x) { return cf{u.x - x.y, u.y + x.x}; }
#endif
template <int N, bool PEND = false> FD void dif(cf* a, const FftK& K) {
#pragma unroll
    for (int k = 0; k < N / 2; ++k) { cf u, v;
        if (PEND && k == 0) { u = add_mi(a[0], a[N / 2]); v = add_pi(a[0], a[N / 2]); } else { u = cadd(a[k], a[k + N / 2]); v = csub(a[k], a[k + N / 2]); }
        a[k] = u; a[k + N / 2] = (N >= 4 && k == N / 4) ? v : mulw32(v, k * (32 / N), false, K); }
    if constexpr (N > 2) { dif<N / 2, false>(a, K); dif<N / 2, (N >= 4)>(a + N / 2, K); }
}
template <int N> FD void idif(cf* a, const FftK& K) {
    if constexpr (N > 2) { idif<N / 2>(a, K); idif<N / 2>(a + N / 2, K); }
#pragma unroll
    for (int k = 0; k < N / 2; ++k) {
        if (N >= 4 && k == N / 4) { const cf u = a[k], x = a[k + N / 2]; a[k] = add_pi(u, x); a[k + N / 2] = add_mi(u, x); }
        else { const cf t = mulw32(a[k + N / 2], k * (32 / N), true, K), u = a[k]; a[k] = cadd(u, t); a[k + N / 2] = csub(u, t); } }
}
FD constexpr int brev4(int r) { return ((r & 1) << 3) | ((r & 2) << 1) | ((r & 4) >> 1) | ((r & 8) >> 3); }
FD int fphys(int e) { return e + (e >> 5); }
constexpr int FFT_BUF = 8192 + 256;
FD void powers16(cf w, cf* pw) {
    pw[0] = cf{1.0f, 0.0f}; pw[1] = w; pw[2] = cmul(w, w); pw[3] = cmul(pw[2], w); pw[4] = cmul(pw[2], pw[2]); pw[5] = cmul(pw[4], w); pw[6] = cmul(pw[4], pw[2]); pw[7] = cmul(pw[4], pw[3]);
    pw[8] = cmul(pw[4], pw[4]); pw[9] = cmul(pw[8], w); pw[10] = cmul(pw[8], pw[2]); pw[11] = cmul(pw[8], pw[3]); pw[12] = cmul(pw[8], pw[4]); pw[13] = cmul(pw[8], pw[5]); pw[14] = cmul(pw[8], pw[6]); pw[15] = cmul(pw[8], pw[7]);
}
template <int PS> FD void f16_store(cf* a, const cf* pw, LASQ cf* buf, int pb, const FftK& K) {
    dif<16>(a, K);
#pragma unroll
    for (int r = 0; r < 16; ++r) { const cf v = (r == 0) ? a[0] : cmul(a[r], pw[brev4(r)]); fst_(buf + pb, PS * r, v); }
}
template <int PS> FD void i16_load(cf* a, const cf* pw, const LASQ cf* buf, int pb, const FftK& K) {
#pragma unroll
    for (int r = 0; r < 16; ++r) { const cf v = fld_(buf + pb, PS * r); a[r] = (r == 0) ? v : cmulc(v, pw[brev4(r)]); }
    idif<16>(a, K);
}
FD void fft_pass_f2(LASQ cf* bufE, LASQ cf* bufO, const LASQ cf* w512, int t) {
    const FftK K = fft_consts();
    const int i2 = t & 31, pb = (t >> 5) * 528 + i2; cf pw[16]; powers16(fld_(w512, i2), pw); cf a[16];
#pragma unroll
    for (int j = 0; j < 16; ++j) a[j] = fld_(bufE + pb, 33 * j);
    f16_store<33>(a, pw, bufE, pb, K);
#pragma unroll
    for (int j = 0; j < 16; ++j) a[j] = fld_(bufO + pb, 33 * j);
    f16_store<33>(a, pw, bufO, pb, K);
}
FD void fft_pass_i2(LASQ cf* bufE, LASQ cf* bufO, const LASQ cf* w512, int t) {
    const FftK K = fft_consts();
    const int i2 = t & 31, pb = (t >> 5) * 528 + i2; cf pw[16]; powers16(fld_(w512, i2), pw); cf a[16];
    i16_load<33>(a, pw, bufE, pb, K);
#pragma unroll
    for (int j = 0; j < 16; ++j) fst_(bufE + pb, 33 * j, a[j]);
    i16_load<33>(a, pw, bufO, pb, K);
#pragma unroll
    for (int j = 0; j < 16; ++j) fst_(bufO + pb, 33 * j, a[j]);
}
FD int f3_pipe(int t) { return (t >> 5) & 1; }
FD int f3_blk(int t) { return ((t >> 6) << 5) + (t & 31); }
FD void fft_f3_load(cf* a, const LASQ cf* bufE, const LASQ cf* bufO, int t) {
    const LASQ cf* b = f3_pipe(t) ? bufO : bufE; const int base = f3_blk(t) * 33;
#pragma unroll
    for (int r = 0; r < 32; ++r) a[r] = fld_(b, base + r);
    dif<32>(a, fft_consts());
}
FD void fft_i3_store(cf* a, LASQ cf* bufE, LASQ cf* bufO, int t) {
    idif<32>(a, fft_consts());
    LASQ cf* b = f3_pipe(t) ? bufO : bufE; const int base = f3_blk(t) * 33;
#pragma unroll
    for (int r = 0; r < 32; ++r) fst_(b, base + r, a[r]);
}
constexpr int FL_BUFE = 0, FL_BUFO = FFT_BUF * 8, FL_W16 = 2 * FFT_BUF * 8, FL_W8 = FL_W16 + 4096, FL_W512 = FL_W8 + 4096, FL_RED = FL_W512 + 256;
static_assert(FL_RED + 64 <= LDS_BYTES - 16, "fft LDS map");
__device__ __forceinline__ void fft_tables(const Ctx& c) {
    LAS cf* W16 = (LAS cf*)(c.lds + FL_W16); LAS cf* W8 = (LAS cf*)(c.lds + FL_W8); LAS cf* w512 = (LAS cf*)(c.lds + FL_W512);
    { float s, co; sincospif((float)c.tid * (1.0f / 8192.0f), &s, &co); fst_(W16, c.tid, cf{co, -s}); sincospif((float)c.tid * (1.0f / 4096.0f), &s, &co); fst_(W8, c.tid, cf{co, -s});
      if (c.tid < 32) { sincospif((float)c.tid * (1.0f / 256.0f), &s, &co); fst_(w512, c.tid, cf{co, -s}); } }
    __syncthreads();
}
__device__ __forceinline__ int fresh(int t) { asm volatile("" : "+v"(t)); return t; }
__device__ __forceinline__ void fft_forward12(const cf* zE, const cf* zO, const Ctx& c, int tid_) {
    LAS cf* bufE = (LAS cf*)(c.lds + FL_BUFE); LAS cf* bufO = (LAS cf*)(c.lds + FL_BUFO); const LAS cf* W8 = (const LAS cf*)(c.lds + FL_W8); const LAS cf* w512 = (const LAS cf*)(c.lds + FL_W512);
    { const FftK K = fft_consts(); const int t1 = fresh(tid_); cf pw[16]; powers16(fld_(W8, t1), pw); cf a[16];
#pragma unroll
      for (int j = 0; j < 16; ++j) a[j] = zE[j];
      f16_store<528>(a, pw, bufE, t1 + (t1 >> 5), K);
#pragma unroll
      for (int j = 0; j < 16; ++j) a[j] = zO[j];
      f16_store<528>(a, pw, bufO, t1 + (t1 >> 5), K); }
    __syncthreads();
    fft_pass_f2(bufE, bufO, w512, fresh(tid_));
    LDS_WAIT(); asm volatile("" ::: "memory");
}
typedef _Float16 h16x4 __attribute__((ext_vector_type(4)));
struct Sc3Raw { unsigned short own[2][16], nb[2][16]; };
__device__ __forceinline__ void sc3_load_row(const bf16_t* row, int tq, unsigned short (&own)[16], unsigned short (&nb)[16]) {
    const int d = ((tq & 63) == 0) ? -1 : 1; const bf16_t* p = row + tq; const bf16_t* q = p + d;
#pragma unroll
    for (int j = 0; j < 16; ++j) own[j] = p[512 * j];
#pragma unroll
    for (int j = 0; j < 16; ++j) nb[j] = (j == 0) ? row[max(tq + d, 0)] : (j == 15) ? row[min(tq + 7680 + d, S - 1)] : q[512 * j];
}
__device__ __forceinline__ float sc3_eval(unsigned short own, unsigned short nb, int j, int n, float w0, float w1, float w2, float bb) {
    const float x0 = bf2f(own), xh = bf2f(nb);
    const float oldm = (j > 0 || n > 0) ? xh : 0.f, oldp = (j < 15 || n < S - 1) ? xh : 0.f;
    const float xm = __int_as_float(__builtin_amdgcn_update_dpp(__float_as_int(oldm), __float_as_int(x0), 0x138, 0xF, 0xF, false));
    const float xp = __int_as_float(__builtin_amdgcn_update_dpp(__float_as_int(oldp), __float_as_int(x0), 0x130, 0xF, 0xF, false));
    return xm * w0 + x0 * w1 + xp * w2 + bb;
}
template <bool PRE = false>
__device__ __forceinline__ void fft_conv(cf* z, const h16x4* Kb, const Ctx& c, Sc3Raw* pre = nullptr, const bf16_t* ra = nullptr, const bf16_t* rb = nullptr) {
    LAS cf* bufE = (LAS cf*)(c.lds + FL_BUFE); LAS cf* bufO = (LAS cf*)(c.lds + FL_BUFO); const LAS cf* W16 = (const LAS cf*)(c.lds + FL_W16); const LAS cf* W8 = (const LAS cf*)(c.lds + FL_W8); const LAS cf* w512 = (const LAS cf*)(c.lds + FL_W512);
    { const FftK K = fft_consts(); cf zO[16]; const cf w16 = fld_(W16, fresh(c.tid));
#pragma unroll
      for (int j = 0; j < 16; ++j) zO[j] = cmul(z[j], mulw32(w16, j, false, K));
      fft_forward12(z, zO, c, c.tid); }
    { const int t3 = fresh(c.tid); cf a[32]; h16x4 kk[16];
#pragma unroll
      for (int g = 0; g < 16; ++g) kk[g] = Kb[g * 512 + t3];
      fft_f3_load(a, bufE, bufO, t3);
#pragma unroll
      for (int g = 0; g < 16; ++g) { a[2 * g] = cmul(a[2 * g], cf{(float)kk[g][0], (float)kk[g][1]}); a[2 * g + 1] = cmul(a[2 * g + 1], cf{(float)kk[g][2], (float)kk[g][3]}); }
      fft_i3_store(a, bufE, bufO, t3); }
    LDS_WAIT(); asm volatile("" ::: "memory");
    fft_pass_i2(bufE, bufO, w512, fresh(c.tid));
    __syncthreads();
    if constexpr (PRE) { const int tq = fresh(c.tid);
        sc3_load_row(ra, tq, pre->own[0], pre->nb[0]); sc3_load_row(rb, tq, pre->own[1], pre->nb[1]); }
    { const FftK K = fft_consts(); const int t5 = fresh(c.tid); cf pw[16]; powers16(fld_(W8, t5), pw); cf aO[16]; const cf w16 = fld_(W16, t5);
      i16_load<528>(z, pw, bufE, t5 + (t5 >> 5), K); i16_load<528>(aO, pw, bufO, t5 + (t5 >> 5), K);
#pragma unroll
      for (int j = 0; j < 16; ++j) { const cf s_ = cadd(z[j], cmulc(aO[j], mulw32(w16, j, false, K))); z[j] = cf{s_.x * (1.0f / 16384.0f), s_.y * (1.0f / 16384.0f)}; } }
}
__device__ __forceinline__ void kspec_phase(const Ctx& c0) { PH_ENTER();
    fft_tables(c);
    LAS cf* bufE = (LAS cf*)(c.lds + FL_BUFE); LAS cf* bufO = (LAS cf*)(c.lds + FL_BUFO); const LAS cf* W16 = (const LAS cf*)(c.lds + FL_W16); LAS float* red = (LAS float*)(c.lds + FL_RED);
    const _Float16* kt = (const _Float16*)(c.ws + WS_KT); const float* l1p = (const float*)(c.ws + WS_L1P); h16x4* KF = (h16x4*)(c.ws + WS_KF);
    for (int pr = c.vcu; pr < DEPTH * 2 * 256; pr += c.G) { const int it = 2 * pr, l = it >> 10, o = (it >> 9) & 1, ch = it & 511;
        float pa = 0.f, pb = 0.f;
        if (c.tid < 64) { const float* lp = l1p + ((size_t)l * 64 + c.tid) * 2048 + o * 512 + ch; pa = lp[0] + lp[1024]; pb = lp[1] + lp[1025]; }
        float sa, sb;
        { const int tr = fresh(c.tid); const float wa = wave_sum(pa, tr & 63), wb = wave_sum(pb, tr & 63);
          __syncthreads(); if ((tr & 63) == 0) { red[tr >> 6] = wa; red[8 + (tr >> 6)] = wb; } __syncthreads();
          float s0 = 0.f, s1 = 0.f;
#pragma unroll
          for (int i = 0; i < 8; ++i) { s0 += red[i]; s1 += red[8 + i]; }
          sa = 1.0f / s0; sb = 1.0f / s1; }
        const _Float16* kra = kt + (size_t)it * 16384; const _Float16* krb = kra + 16384;
        const float hba = p->in[I_HBIAS][l * 1024 + o * 512 + ch], hbb = p->in[I_HBIAS][l * 1024 + o * 512 + ch + 1];
        { const FftK K = fft_consts(); cf zE[16], zO[16]; const int t1 = fresh(c.tid); const cf w16 = fld_(W16, t1);
#pragma unroll
          for (int j = 0; j < 16; ++j) { const int n = t1 + 512 * j; const float a0 = (float)kra[n] * sa, a1 = (float)kra[n + 8192] * sa, b0 = (float)krb[n] * sb, b1 = (float)krb[n + 8192] * sb;
              zE[j] = cf{a0 + a1, b0 + b1}; zO[j] = cmul(cf{a0 - a1, b0 - b1}, mulw32(w16, j, false, K)); }
          fft_forward12(zE, zO, c, c.tid); }
        { const int t3 = fresh(c.tid); cf a[32]; fft_f3_load(a, bufE, bufO, t3);
          LAS cf* b = f3_pipe(t3) ? bufO : bufE; const int blk = f3_blk(t3), base = blk * 33;
#pragma unroll
          for (int r = 0; r < 32; ++r) fst_(b, base + r, a[r]);
          __syncthreads();
          h16x4* Ka = KF + (size_t)it * 8192; h16x4* Kb = Ka + 8192;
#pragma unroll
          for (int g = 0; g < 16; ++g) { float ka[4], kb[4];
#pragma unroll
              for (int u = 0; u < 2; ++u) { const int r = 2 * g + u; const unsigned pos = (unsigned)(blk * 32 + r);
                  const unsigned mp = f3_pipe(t3) ? 8191u - pos : (__builtin_bitreverse32((8192u - (__builtin_bitreverse32(pos) >> 19)) & 8191u) >> 19);
                  const cf m = fld_(b, (int)((mp >> 5) * 33u + (mp & 31u))); const cf z = a[r];
                  ka[2 * u] = 0.5f * (z.x + m.x) + hba; ka[2 * u + 1] = 0.5f * (z.y - m.y); kb[2 * u] = 0.5f * (z.y + m.y) + hbb; kb[2 * u + 1] = 0.5f * (m.x - z.x); }
              Ka[g * 512 + t3] = (h16x4){(_Float16)ka[0], (_Float16)ka[1], (_Float16)ka[2], (_Float16)ka[3]};
              Kb[g * 512 + t3] = (h16x4){(_Float16)kb[0], (_Float16)kb[1], (_Float16)kb[2], (_Float16)kb[3]}; } }
        __syncthreads();
    }
}
__device__ __forceinline__ float sc3(const bf16_t* row, int n, int lane, float w0, float w1, float w2, float bb) {
    const float x0 = bf2f(row[n]); const int nh = (lane == 0) ? max(n - 1, 0) : min(n + 1, S - 1); const float xh = bf2f(row[nh]);
    const float su = lane_prev(x0), sd = lane_next(x0);
    const float xm = (lane == 0) ? (n > 0 ? xh : 0.f) : su, xp = (lane == 0) ? sd : (n < S - 1 ? xh : 0.f);
    return xm * w0 + x0 * w1 + xp * w2 + bb;
}
__device__ __forceinline__ void hyena_fft_phase(const Ctx& c0, int l) { PH_ENTER();
    fft_tables(c);
    const bf16_t* P1 = (const bf16_t*)(c.ws + WS_P1); bf16_t* YT = (bf16_t*)(c.ws + WS_YHYT); const h16x4* KF = (const h16x4*)(c.ws + WS_KF);
    const float* cw = p->in[I_CW] + l * 3 * 1536; const float* cb = p->in[I_CB] + l * 1536;
    const int per = (1024 + c.G - 1) / c.G;
#ifdef HY_REP
    int hyrep = HY_REP; asm volatile("" : "+s"(hyrep));
#else
    const int hyrep = 1;
#endif
    Sc3Raw Rv;
#define HY_LOADV(itx) do { const int chx_ = (itx) >> 1, prx_ = (itx) & 1; const bf16_t* rvx_ = P1 + (size_t)(1024 + chx_) * T + (size_t)(2 * prx_) * S; const int tx_ = fresh(c.tid); \
        sc3_load_row(rvx_, tx_, Rv.own[0], Rv.nb[0]); sc3_load_row(rvx_ + S, tx_, Rv.own[1], Rv.nb[1]); } while (0)
    if (c.vcu * per < 1024) HY_LOADV(c.vcu * per);
    for (int kk = 0; kk < per * hyrep; ++kk) { const int k = kk % per; const int it = c.vcu * per + k; if (it >= 1024) break;
        const int ch = it >> 1, pr = it & 1; const size_t ba = (size_t)(2 * pr) * S, bb = ba + S;
        const bf16_t* rx1 = P1 + (size_t)ch * T; const bf16_t* rx2 = P1 + (size_t)(512 + ch) * T; const bf16_t* rv = P1 + (size_t)(1024 + ch) * T;
        const float wv0 = cw[1024 + ch], wv1 = cw[1536 + 1024 + ch], wv2 = cw[3072 + 1024 + ch], bv = cb[1024 + ch];
        const float wa0 = cw[ch], wa1 = cw[1536 + ch], wa2 = cw[3072 + ch], bxa = cb[ch];
        const float wb0 = cw[512 + ch], wb1 = cw[1536 + 512 + ch], wb2 = cw[3072 + 512 + ch], bxb = cb[512 + ch];
        cf z[16]; Sc3Raw R; const int ta = fresh(c.tid);
#pragma unroll
        for (int j = 0; j < 16; ++j) { const int n = ta + 512 * j; z[j] = cf{sc3_eval(Rv.own[0][j], Rv.nb[0][j], j, n, wv0, wv1, wv2, bv), sc3_eval(Rv.own[1][j], Rv.nb[1][j], j, n, wv0, wv1, wv2, bv)}; }
        asm volatile("" ::: "memory"); fft_conv<true>(z, KF + (size_t)((l * 2 + 0) * 512 + ch) * 8192, c, &R, rx1 + ba, rx1 + bb); asm volatile("" ::: "memory");
        const int tb = fresh(c.tid);
#pragma unroll
        for (int j = 0; j < 16; ++j) { const int n = tb + 512 * j; z[j] = cf{sc3_eval(R.own[0][j], R.nb[0][j], j, n, wa0, wa1, wa2, bxa) * z[j].x, sc3_eval(R.own[1][j], R.nb[1][j], j, n, wa0, wa1, wa2, bxa) * z[j].y}; }
        asm volatile("" ::: "memory"); fft_conv<true>(z, KF + (size_t)((l * 2 + 1) * 512 + ch) * 8192, c, &R, rx2 + ba, rx2 + bb); asm volatile("" ::: "memory");
        { const int kn_ = (kk + 1) % per, itn_ = c.vcu * per + kn_; HY_LOADV(itn_ < 1024 ? itn_ : it); }
        const int tc = fresh(c.tid);
#pragma unroll
        for (int j = 0; j < 16; ++j) { const int n = tc + 512 * j;
            const float oa = sc3_eval(R.own[0][j], R.nb[0][j], j, n, wb0, wb1, wb2, bxb) * z[j].x, ob = sc3_eval(R.own[1][j], R.nb[1][j], j, n, wb0, wb1, wb2, bxb) * z[j].y;
            YT[(size_t)ch * T + ba + n] = (bf16_t)f2bf(oa); YT[(size_t)ch * T + bb + n] = (bf16_t)f2bf(ob); }
    }
}
constexpr int RT_S64 = 144, RT_S128 = 272;
__device__ __forceinline__ void load_tile(LAS unsigned char* dst, int stride, const bf16_t* g, size_t ld, int rows, int cpr  , int tid) {
    for (int idx = tid; idx < rows * cpr; idx += NT) { const int r = idx / cpr, cc = idx % cpr; *(LAS u32x4*)(dst + r * stride + cc * 16) = *(const u32x4*)(g + (size_t)r * ld + cc * 8); }
}
__device__ __forceinline__ bf16x8 ld_frag(const LAS unsigned char* tile, int stride, int row, int kel) { return *(const LAS bf16x8*)(tile + row * stride + kel * 2); }
#define RT_MFMA(x, y, acc) __builtin_amdgcn_mfma_f32_16x16x32_bf16((x), (y), (acc), 0, 0, 0)
__device__ __forceinline__ float ret_lgf(int h) { return log2f(1.0f - exp2f(-(5.0f + (float)h))); }
__device__ __forceinline__ float ret_lgb(int h) { return log2f(1.0f - exp2f(-(5.5f + (float)h))); }

struct RaRegs { u32x4 v[4], k[2]; };
__device__ __forceinline__ void ra_fetch(RaRegs& R, const bf16_t* P1, const bf16_t* P2, int it, int tid) {
    tid = fresh(tid);
    const int b = it >> 8, h = (it >> 6) & 3, n = it & 63; const size_t t0 = (size_t)b * S + n * 128;
#pragma unroll
    for (int u = 0; u < 4; ++u) { const int idx = tid + NT * u, r16 = idx >> 4, c16 = idx & 15; R.v[u] = *(const u32x4*)(P1 + (size_t)(1536 + h * 128 + r16) * T + t0 + c16 * 8); }
#pragma unroll
    for (int u = 0; u < 2; ++u) { const int idx = tid + NT * u, j = idx >> 3, dc = idx & 7; R.k[u] = *(const u32x4*)(P2 + (t0 + j) * P2C + 256 + h * 64 + dc * 8); }
}
__device__ __forceinline__ void ret_sums_phase(const Ctx& c0, int l) { PH_ENTER(); (void)p; (void)l;
    LAS unsigned char* VT = c.lds; LAS unsigned char* KfT = c.lds + 34816; LAS unsigned char* KbT = c.lds + 52224;
    const bf16_t* P1 = (const bf16_t*)(c.ws + WS_P1); const bf16_t* P2 = (const bf16_t*)(c.ws + WS_P2); bf16_t* KVS = (bf16_t*)(c.ws + WS_KVS);
    const int fr = c.lane & 15, fq = c.lane >> 4;
    RaRegs R;
    if (c.vcu < NB * 4 * 64) ra_fetch(R, P1, P2, c.vcu, c.tid);
    for (int it = c.vcu; it < NB * 4 * 64; it += c.G) { const int h = (it >> 6) & 3;
        const float lgf = ret_lgf(h), lgb = ret_lgb(h);
        __syncthreads();
        { const int tw_ = fresh(c.tid);
#pragma unroll
          for (int u = 0; u < 4; ++u) { const int idx = tw_ + NT * u, r16 = idx >> 4, c16 = idx & 15; *(LAS u32x4*)(VT + r16 * RT_S128 + c16 * 16) = R.v[u]; }
#pragma unroll
          for (int u2 = 0; u2 < 2; ++u2) { const int idx = tw_ + NT * u2, j = idx >> 3, dc = idx & 7; const u32x4 kv = R.k[u2];
            const float wf = __builtin_amdgcn_exp2f((float)(127 - j) * lgf), wb = __builtin_amdgcn_exp2f((float)j * lgb); const unsigned kw[4] = {kv.x, kv.y, kv.z, kv.w};
#pragma unroll
            for (int u = 0; u < 8; ++u) { const float kvl = (u & 1) ? bf_hi(kw[u >> 1]) : bf_lo(kw[u >> 1]);
                *(LAS bf16_t*)(KfT + (dc * 8 + u) * RT_S128 + j * 2) = (bf16_t)f2bf(kvl * wf); *(LAS bf16_t*)(KbT + (dc * 8 + u) * RT_S128 + j * 2) = (bf16_t)f2bf(kvl * wb); } } }
        if (it + c.G < NB * 4 * 64) ra_fetch(R, P1, P2, it + c.G, c.tid);
        __syncthreads();
        bf16x8 vf[4];
#pragma unroll
        for (int ks = 0; ks < 4; ++ks) vf[ks] = ld_frag(VT, RT_S128, 16 * c.wave + fr, 32 * ks + 8 * fq);
#pragma unroll
        for (int dir = 0; dir < 2; ++dir) { const LAS unsigned char* KT = dir ? KbT : KfT;
#pragma unroll
            for (int db = 0; db < 4; ++db) { f32x4 acc = {0.f, 0.f, 0.f, 0.f};
#pragma unroll
                for (int ks = 0; ks < 4; ++ks) acc = RT_MFMA(ld_frag(KT, RT_S128, 16 * db + fr, 32 * ks + 8 * fq), vf[ks], acc);
                u32x2 w; w.x = pg8::cvt_pk_bf16(acc[0], acc[1]); w.y = pg8::cvt_pk_bf16(acc[2], acc[3]);
                *(u32x2*)(KVS + ((size_t)it * 2 + dir) * 8192 + (16 * c.wave + fr) * 64 + 16 * db + 4 * fq) = w; } }
    }
}
__device__ __forceinline__ void ret_scan_phase(const Ctx& c0, int l) { PH_ENTER(); (void)p; (void)l;
    const bf16_t* KVS = (const bf16_t*)(c.ws + WS_KVS); bf16_t* PT = (bf16_t*)(c.ws + WS_KVP);
    for (int idx = c.vcu * NT + c.tid; idx < 16 * 2 * 4096; idx += c.G * NT) { const int e = (idx & 4095) * 2, dir = (idx >> 12) & 1, bh = idx >> 13, h = bh & 3;
        const float cd = exp2f(128.0f * (dir ? ret_lgb(h) : ret_lgf(h))); float s0 = 0.f, s1 = 0.f;
        unsigned kv[64];
#pragma unroll
        for (int u = 0; u < 64; ++u) { const int n = dir ? 63 - u : u; kv[u] = *(const unsigned*)(KVS + ((size_t)(bh * 64 + n) * 2 + dir) * 8192 + e); }
#pragma unroll
        for (int u = 0; u < 64; ++u) { const int n = dir ? 63 - u : u; *(unsigned*)(PT + ((size_t)(bh * 64 + n) * 2 + dir) * 8192 + e) = pk2(s0, s1); s0 = s0 * cd + bf_lo(kv[u]); s1 = s1 * cd + bf_hi(kv[u]); }
    }
}
struct RcRegs { u32x4 q[2], k[2], v[4], pf[2], pb[2]; };
__device__ __forceinline__ void rc_fetch(RcRegs& R, const bf16_t* P1, const bf16_t* P2, const bf16_t* PT, int it, int tid) {
    tid = fresh(tid);
    const int b = it >> 8, h = (it >> 6) & 3, n = it & 63; const size_t t0 = (size_t)b * S + n * 128;
#pragma unroll
    for (int u = 0; u < 2; ++u) { const int idx = tid + NT * u, r8 = idx >> 3, c8 = idx & 7;
        R.q[u] = *(const u32x4*)(P2 + (t0 + r8) * P2C + h * 64 + c8 * 8); R.k[u] = *(const u32x4*)(P2 + (t0 + r8) * P2C + 256 + h * 64 + c8 * 8);
        R.pf[u] = *(const u32x4*)(PT + ((size_t)it * 2 + 0) * 8192 + r8 * 64 + c8 * 8); R.pb[u] = *(const u32x4*)(PT + ((size_t)it * 2 + 1) * 8192 + r8 * 64 + c8 * 8); }
#pragma unroll
    for (int u = 0; u < 4; ++u) { const int idx = tid + NT * u, r16 = idx >> 4, c16 = idx & 15; R.v[u] = *(const u32x4*)(P1 + (size_t)(1536 + h * 128 + r16) * T + t0 + c16 * 8); }
}
__device__ __forceinline__ void ret_out_phase(const Ctx& c0, int l) { PH_ENTER(); (void)p; (void)l;
    LAS unsigned char* Kt = c.lds; LAS unsigned char* Qt = c.lds + 18432; LAS unsigned char* VT = c.lds + 36864; LAS unsigned char* Pm = c.lds + 71680; LAS unsigned char* PfT = c.lds + 106496; LAS unsigned char* PbT = c.lds + 124928;
    const bf16_t* P1 = (const bf16_t*)(c.ws + WS_P1); const bf16_t* P2 = (const bf16_t*)(c.ws + WS_P2); const bf16_t* PT = (const bf16_t*)(c.ws + WS_KVP); bf16_t* YR = (bf16_t*)(c.ws + WS_YRET);
    const int fr = c.lane & 15, fq = c.lane >> 4, i0 = 16 * c.wave, i = i0 + fr;
    RcRegs R;
    if (c.vcu < NB * 4 * 64) rc_fetch(R, P1, P2, PT, c.vcu, c.tid);
    for (int it = c.vcu; it < NB * 4 * 64; it += c.G) { const int b = it >> 8, h = (it >> 6) & 3, n = it & 63; const size_t t0 = (size_t)b * S + n * 128;
        const float lgf = ret_lgf(h), lgb = ret_lgb(h);
        __syncthreads();
        const int tw_ = fresh(c.tid);
#pragma unroll
        for (int u = 0; u < 2; ++u) { const int idx = tw_ + NT * u, r8 = idx >> 3, c8 = idx & 7;
            *(LAS u32x4*)(Qt + r8 * RT_S64 + c8 * 16) = R.q[u]; *(LAS u32x4*)(Kt + r8 * RT_S64 + c8 * 16) = R.k[u]; *(LAS u32x4*)(PfT + r8 * RT_S64 + c8 * 16) = R.pf[u]; *(LAS u32x4*)(PbT + r8 * RT_S64 + c8 * 16) = R.pb[u]; }
#pragma unroll
        for (int u = 0; u < 4; ++u) { const int idx = tw_ + NT * u, r16 = idx >> 4, c16 = idx & 15; *(LAS u32x4*)(VT + r16 * RT_S128 + c16 * 16) = R.v[u]; }
        const size_t t = t0 + i;
        u32x2 gw[8];
#pragma unroll
        for (int vb = 0; vb < 8; ++vb) gw[vb] = *(const u32x2*)(P2 + t * P2C + 512 + h * 128 + 16 * vb + 4 * fq);
        if (it + c.G < NB * 4 * 64) rc_fetch(R, P1, P2, PT, it + c.G, c.tid);
        __syncthreads();
        bf16x8 qf[2];
#pragma unroll
        for (int ks = 0; ks < 2; ++ks) qf[ks] = ld_frag(Qt, RT_S64, i, 32 * ks + 8 * fq);
#pragma unroll
        for (int jb = 0; jb < 8; ++jb) { f32x4 s = {0.f, 0.f, 0.f, 0.f};
#pragma unroll
            for (int ks = 0; ks < 2; ++ks) s = RT_MFMA(ld_frag(Kt, RT_S64, 16 * jb + fr, 32 * ks + 8 * fq), qf[ks], s);
            float pv[4];
#pragma unroll
            for (int r = 0; r < 4; ++r) { const int dl = i - (16 * jb + 4 * fq + r); pv[r] = s[r] * __builtin_amdgcn_exp2f(dl >= 0 ? (float)dl * lgf : (float)(-dl) * lgb); }
            u32x2 w; w.x = pk2(pv[0], pv[1]); w.y = pk2(pv[2], pv[3]);
            *(LAS u32x2*)(Pm + i * RT_S128 + (16 * jb + 4 * fq) * 2) = w; }
        asm volatile("s_waitcnt lgkmcnt(0)" ::: "memory");
        bf16x8 pf[4];
#pragma unroll
        for (int ks = 0; ks < 4; ++ks) pf[ks] = ld_frag(Pm, RT_S128, i, 32 * ks + 8 * fq);
        const float sf = __builtin_amdgcn_exp2f((float)(i + 1) * lgf), sb = __builtin_amdgcn_exp2f((float)(128 - i) * lgb);
        f32x4 o[8]; float ss = 0.f;
#pragma unroll
        for (int vb = 0; vb < 8; ++vb) { f32x4 a = {0.f, 0.f, 0.f, 0.f}, cf_ = {0.f, 0.f, 0.f, 0.f}, cb_ = {0.f, 0.f, 0.f, 0.f};
#pragma unroll
            for (int ks = 0; ks < 4; ++ks) a = RT_MFMA(ld_frag(VT, RT_S128, 16 * vb + fr, 32 * ks + 8 * fq), pf[ks], a);
#pragma unroll
            for (int ks = 0; ks < 2; ++ks) { cf_ = RT_MFMA(ld_frag(PfT, RT_S64, 16 * vb + fr, 32 * ks + 8 * fq), qf[ks], cf_); cb_ = RT_MFMA(ld_frag(PbT, RT_S64, 16 * vb + fr, 32 * ks + 8 * fq), qf[ks], cb_); }
            o[vb] = a + sf * cf_ + sb * cb_; ss += (o[vb][0] * o[vb][0] + o[vb][1] * o[vb][1]) + (o[vb][2] * o[vb][2] + o[vb][3] * o[vb][3]); }
        ss += swz_xor<16>(ss); ss += xor32(ss, c.lane);
        const float rn = __builtin_amdgcn_rsqf(ss * (1.0f / 128.0f) + EPS);
#pragma unroll
        for (int vb = 0; vb < 8; ++vb) { const int col = h * 128 + 16 * vb + 4 * fq;
            const float g0 = bf_lo(gw[vb].x), g1 = bf_hi(gw[vb].x), g2 = bf_lo(gw[vb].y), g3 = bf_hi(gw[vb].y);
            u32x2 w; w.x = pk2(o[vb][0] * rn * (g0 * sigmoidf_(g0)), o[vb][1] * rn * (g1 * sigmoidf_(g1))); w.y = pk2(o[vb][2] * rn * (g2 * sigmoidf_(g2)), o[vb][3] * rn * (g3 * sigmoidf_(g3)));
            *(u32x2*)(YR + t * 512 + col) = w; }
    }
}
constexpr int FG_H3 = 82432, FG_W4T = 100864, FG_S = 144;
__device__ __forceinline__ void filters_phase(const Ctx& c0) { PH_ENTER();
    LAS float* feat = (LAS float*)c.lds;
    LAS float* hA = (LAS float*)(c.lds + 16896);
    LAS float* hB = (LAS float*)(c.lds + 49664);
    LAS unsigned char* H3 = c.lds + FG_H3;
    LAS unsigned char* W4T = c.lds + FG_W4T;
    _Float16* kt = (_Float16*)(c.ws + WS_KT); float* l1p = (float*)(c.ws + WS_L1P);
    const float min_decay = logf(1e-2f) / 1.5f, max_decay = logf(1e-2f) / 0.3f;
    const int fr = c.lane & 15, fq = c.lane >> 4;
    for (int it = c.vcu; it < DEPTH * 64; it += c.G) { const int l = it >> 6, pb_ = it & 63, p0 = pb_ * 128;
        const float* w1 = p->in[I_W1] + l * 33 * 64; const float* b1 = p->in[I_B1] + l * 64; const float* w2 = p->in[I_W2] + l * 4096; const float* b2 = p->in[I_B2] + l * 64;
        const float* w3 = p->in[I_W3] + l * 4096; const float* b3 = p->in[I_B3] + l * 64; const float* w4 = p->in[I_W4] + (size_t)l * 64 * 2048; const float* frq = p->in[I_FREQ] + l * 64;
        __syncthreads();
        for (int idx = c.tid; idx < 128 * 33; idx += NT) { const int pp = idx / 33, j = idx % 33; const int pos = p0 + pp; float v;
            if (j == 0) v = (float)pos / 8191.0f;
            else { const float w = 6.283185307179586f * (float)pos / 8192.0f; const int jj = (j - 1) & 15; const float f = 1e-4f + (float)jj * ((15.0f - 1e-4f) / 15.0f);
                v = j <= 16 ? cosf(f * w) : -sinf(f * w); }
            feat[idx] = v; }
        __syncthreads();
        { const int tm = fresh(c.tid), n = tm & 63, pw0 = tm >> 6;
          { float wr_[33];
#pragma unroll
            for (int j = 0; j < 33; ++j) wr_[j] = w1[j * 64 + n];
            const float bn = b1[n], fn = frq[n];
            for (int i = 0; i < 16; ++i) { const int pp = pw0 + 8 * i; float s = bn;
#pragma unroll
                for (int j = 0; j < 33; ++j) s += feat[pp * 33 + j] * wr_[j];
                hA[pp * 64 + n] = sinf(fn * s); } }
          __syncthreads();
          { float wr_[64];
#pragma unroll
            for (int j = 0; j < 64; ++j) wr_[j] = w2[j * 64 + n];
            const float bn = b2[n], fn = frq[n];
            for (int i = 0; i < 16; ++i) { const int pp = pw0 + 8 * i; float s = bn;
#pragma unroll
                for (int q = 0; q < 16; ++q) { const f32x4 h4 = *(const LAS f32x4*)(hA + pp * 64 + 4 * q); s += (h4.x * wr_[4 * q] + h4.y * wr_[4 * q + 1]) + (h4.z * wr_[4 * q + 2] + h4.w * wr_[4 * q + 3]); }
                hB[pp * 64 + n] = sinf(fn * s); } }
          __syncthreads();
          { float wr_[64];
#pragma unroll
            for (int j = 0; j < 64; ++j) wr_[j] = w3[j * 64 + n];
            const float bn = b3[n], fn = frq[n];
            for (int i = 0; i < 16; ++i) { const int pp = pw0 + 8 * i; float s = bn;
#pragma unroll
                for (int q = 0; q < 16; ++q) { const f32x4 h4 = *(const LAS f32x4*)(hB + pp * 64 + 4 * q); s += (h4.x * wr_[4 * q] + h4.y * wr_[4 * q + 1]) + (h4.z * wr_[4 * q + 2] + h4.w * wr_[4 * q + 3]); }
                *(LAS bf16_t*)(H3 + pp * FG_S + n * 2) = (bf16_t)f2bf(sinf(fn * s)); } } }
        for (int ch8 = 0; ch8 < 8; ++ch8) {
            __syncthreads();
            for (int idx = c.tid; idx < 64 * 256; idx += NT) { const int k = idx >> 8, cc = idx & 255; *(LAS bf16_t*)(W4T + cc * FG_S + k * 2) = (bf16_t)f2bf(w4[(size_t)k * 2048 + ch8 * 256 + cc]); }
            __syncthreads();
            bf16x8 y[2][2];
#pragma unroll
            for (int cb = 0; cb < 2; ++cb)
#pragma unroll
                for (int ks = 0; ks < 2; ++ks) y[cb][ks] = *(const LAS bf16x8*)(W4T + (16 * (2 * c.wave + cb) + fr) * FG_S + (32 * ks + 8 * fq) * 2);
            float l1s[2] = {0.f, 0.f};
#pragma unroll
            for (int pb = 0; pb < 8; ++pb) { bf16x8 x[2];
#pragma unroll
                for (int ks = 0; ks < 2; ++ks) x[ks] = *(const LAS bf16x8*)(H3 + (16 * pb + fr) * FG_S + (32 * ks + 8 * fq) * 2);
#pragma unroll
                for (int cb = 0; cb < 2; ++cb) { f32x4 a = {0.f, 0.f, 0.f, 0.f};
                    a = __builtin_amdgcn_mfma_f32_16x16x32_bf16(x[0], y[cb][0], a, 0, 0, 0); a = __builtin_amdgcn_mfma_f32_16x16x32_bf16(x[1], y[cb][1], a, 0, 0, 0);
                    const int col = ch8 * 256 + 16 * (2 * c.wave + cb) + fr, dir = col >> 10, o = (col >> 9) & 1, ch = col & 511, pos = p0 + 16 * pb + 4 * fq;
                    const float delta = fabsf(min_decay + (float)ch * ((max_decay - min_decay) / 511.0f));
                    const float rho = expf(-delta * (1.0f / 8191.0f)); float e = expf(-delta * ((float)pos / 8191.0f)); f32x4 v;
#pragma unroll
                    for (int r = 0; r < 4; ++r) { v[r] = a[r] * e; e *= rho; }
                    _Float16* kr = kt + ((size_t)(l * 2 + o) * 512 + ch) * 16384;
                    typedef _Float16 h16x4f __attribute__((ext_vector_type(4)));
                    if (dir == 0) *(h16x4f*)(kr + pos) = (h16x4f){(_Float16)v[0], (_Float16)v[1], (_Float16)v[2], (_Float16)v[3]};
                    else {
#pragma unroll
                        for (int r = 0; r < 4; ++r) { if (pos + r == 0) { v[r] = 0.f; kr[8192] = (_Float16)0.f; } else kr[16384 - pos - r] = (_Float16)v[r]; } }
                    l1s[cb] += (fabsf(v[0]) + fabsf(v[1])) + (fabsf(v[2]) + fabsf(v[3])); } }
#pragma unroll
            for (int cb = 0; cb < 2; ++cb) { float a = l1s[cb]; a += swz_xor<16>(a); a += xor32(a, c.lane);
                if (fq == 0) l1p[((size_t)l * 64 + pb_) * 2048 + ch8 * 256 + 16 * (2 * c.wave + cb) + fr] = a; }
        }
    }
}
__device__ __forceinline__ void stagger_start(const Ctx& c0, int mul) { int n_ = (int)((c0.bid >> 4) & 3) * mul; asm volatile("" : "+s"(n_)); for (int i_ = 0; i_ < n_; ++i_) __builtin_amdgcn_s_sleep(127); }
#if !defined(ROT) && !defined(ROT2) && !defined(NO_DESYNC)
#define ROT2 1
#define STAGGER 1
#define STAGGER_G 3
#endif
#ifndef STAGGER_U
#define STAGGER_U 127
#endif
#ifndef STG_GU
#define STG_GU 0
#endif
#ifndef STG_DN
#define STG_DN 0
#endif
#ifndef STG_MG
#define STG_MG 0
#endif
#ifndef STG_OUT
#define STG_OUT 0
#endif
__device__ __forceinline__ void inproj_part(const Ctx& c0, int l, int part) { PH_ENTER(); (void)p;
    const bf16_t* H8 = (const bf16_t*)(c.ws + WS_H8A);
    if (part == 0) {
        pg8::Gemm g{(const bf16_t*)(c.ws + WS_WIN1 + (size_t)l * P1R * D), H8, D / 2, D / 2, D / 2, 0};
        pg8::StaticOrder S_; S_.init(P1R, T, c.G, c.bid);
        pg8::EpiPlain E{(bf16_t*)(c.ws + WS_P1), T, 0.03125f};
        pg8::gemm_phase<pg8::EpiPlain, pg8::StaticOrder, false, true>(c.lds, g, S_, E, nullptr, c.tid);
    } else {
        pg8::Gemm g{H8, (const bf16_t*)(c.ws + WS_WIN2 + (size_t)l * P2C * D), D / 2, D / 2, D / 2, 0};
        pg8::StaticOrder S_; S_.init(T, P2C, c.G, c.bid);
        pg8::EpiP2 E{(bf16_t*)(c.ws + WS_P2), (const float*)(c.ws + WS_ROPE), 0.03125f};
        pg8::gemm_phase<pg8::EpiP2, pg8::StaticOrder, false, true>(c.lds, g, S_, E, nullptr, c.tid);
    }
}
__device__ __forceinline__ void inproj_phase(const Ctx& c0, int l) {
#ifdef STAGGER
    { int n_ = (int)((c0.bid >> 4) & STAGGER_G) * STAGGER; asm volatile("" : "+s"(n_)); for (int i_ = 0; i_ < n_; ++i_) __builtin_amdgcn_s_sleep(STAGGER_U); }
#endif
#ifdef ROT2
    { int odd_ = (c0.bid >> 3) & 1; asm volatile("" : "+s"(odd_)); if (odd_) inproj_part(c0, l, 1); }
    inproj_part(c0, l, 0);
    { int odd_ = (c0.bid >> 3) & 1; asm volatile("" : "+s"(odd_)); if (!odd_) inproj_part(c0, l, 1); }
#else
    inproj_part(c0, l, 0); inproj_part(c0, l, 1);
#endif
}
__device__ __forceinline__ void merge_phase(const Ctx& c0, int l) { if (STG_MG) stagger_start(c0, STG_MG); PH_ENTER(); (void)p;
    pg8::Gemm g{(const bf16_t*)(c.ws + WS_YHY), (const bf16_t*)(c.ws + WS_WHY) + (size_t)l * D * 512, 512, 512, 512, (WS_WRET - WS_WHY) / 2, (WS_YRET - WS_YHY) / 2};
    pg8::PairOrder S_; S_.init(T, D, c.G, c.bid);
    pg8::EpiMerge E{(bf16_t*)(c.ws + WS_MRG)};
    pg8::gemm_phase<pg8::EpiMerge, pg8::PairOrder, false>(c.lds, g, S_, E, nullptr, c.tid);
}
__device__ __forceinline__ void outproj_phase(const Ctx& c0, int l, const int dry = 0) { if (STG_OUT) stagger_start(c0, STG_OUT); PH_ENTER();
    pg8::Gemm g{(const bf16_t*)(c.ws + WS_MRG), (const bf16_t*)(c.ws + WS_WOUT) + (size_t)l * D * D, D, D, D, 0};
    pg8::StaticOrder S_; S_.init(T, D, c.G, c.bid);
    pg8::EpiOut E{(bf16_t*)(c.ws + (dry ? WS_KT : WS_X)), l == 0 ? p->in[I_X] : (const float*)nullptr, (const bf16_t*)(c.ws + WS_X), (const float*)(c.ws + WS_MOD) + (size_t)l * NB * 6144 + 2 * 1024};
    pg8::gemm_phase<pg8::EpiOut, pg8::StaticOrder, false>(c.lds, g, S_, E, nullptr, c.tid);
}
__device__ __forceinline__ int moe_tables(const Ctx& c, int l) {
    LAS int* tab = (LAS int*)(c.lds + LDS_TAB); LAS int* tile_e = tab + 128;
    expert_tile_prefix((const unsigned*)(c.ws + WS_CTL) + CW_CNT + l * 32, tab, c.tid);
    __syncthreads();
    const int nMt = tab[64];
    for (int pm = c.tid; pm < nMt; pm += NT) { int e = 0;
#pragma unroll 1
        for (int q = 1; q < 32; ++q) if (tab[q] <= pm * 256) e = q;
        while (e > 0 && ((tab[32 + e] + 255) >> 8) == 0) --e;
        tile_e[pm] = e; }
    __syncthreads();
    return nMt;
}
__device__ __forceinline__ void moe_gu_phase(const Ctx& c0, int l) { if (STG_GU) stagger_start(c0, STG_GU); PH_ENTER();
    LAS int* tab = (LAS int*)(c.lds + LDS_TAB); LAS int* tile_e = tab + 128; LAS int* rowtab = tab + 1024;
    const int nMt = moe_tables(c, l);
    pg8::MoeOrder S_; S_.init(nMt, 2048 / 256, c.G, c.bid, tile_e);
    const int* slot_tok = (const int*)(c.ws + WS_SLOT);
    { pg8::Unit u; for (int ui = 0; S_.next(ui, u); ++ui) { if (c.tid < 256) { const int e = u.e, local = u.pm * 256 - tab[e] + c.tid; rowtab[ui * 256 + c.tid] = local < tab[32 + e] ? slot_tok[e * CAP + local] : 0; } } }
    __syncthreads();
    pg8::Gemm g{(const bf16_t*)(c.ws + WS_H), (const bf16_t*)(c.ws + WS_WGU + (size_t)l * NE * 2048 * D), D / 2, D / 2, D / 2, (size_t)2048 * D / 2};
    pg8::EpiGU8 E{l};
    pg8::gemm_phase<pg8::EpiGU8, pg8::MoeOrder, true, true>(c.lds, g, S_, E, rowtab, c.tid);
}
__device__ __forceinline__ void moe_down_phase(const Ctx& c0, int l) { if (STG_DN) stagger_start(c0, STG_DN); PH_ENTER();
    LAS int* tab = (LAS int*)(c.lds + LDS_TAB); LAS int* tile_e = tab + 128;
    const int nMt = moe_tables(c, l);
    pg8::MoeOrder S_; S_.init(nMt, D / 256, c.G, c.bid, tile_e);
    pg8::Gemm g{(const bf16_t*)(c.ws + WS_ACT), (const bf16_t*)(c.ws + WS_WDN + (size_t)l * NE * D * FF), FF / 2, FF / 2, FF / 2, (size_t)D * FF / 2};
    pg8::EpiDown E{l, 0.03125f};
    pg8::gemm_phase<pg8::EpiDown, pg8::MoeOrder, false, true>(c.lds, g, S_, E, nullptr, c.tid);
}

__device__ __forceinline__ Ctx make_ctx(const Params& p, unsigned char* lds_generic) {
    Ctx c; c.lds = (LAS unsigned char*)lds_generic; c.tid = threadIdx.x; c.lane = c.tid & 63; c.wave = __builtin_amdgcn_readfirstlane(c.tid >> 6);
    c.bid = blockIdx.x; c.G = gridDim.x; c.vcu = (c.G % 8 == 0) ? (c.bid % 8) * (c.G / 8) + c.bid / 8 : c.bid; c.ws = p.ws; return c;
}
__global__ void __launch_bounds__(NT, 2) k_mega(Params p) {
    extern __shared__ __attribute__((aligned(16))) unsigned char lds_raw[];
    const Ctx c = make_ctx(p, lds_raw);
    volatile LAS unsigned* st = (volatile LAS unsigned*)(c.lds + LDS_BYTES - 16);
    if (c.tid == 0) { st[0] = 0u; st[1] = 0u; st[2] = 0u; st[3] = 0u; }
    __syncthreads();
    (void)xcd_barrier_post((unsigned*)(get_kp()->ws + WS_CTL) + CW_BAR, st);
#define GRID_BAR() do { XcdBarrier b_; b_.bar = (unsigned*)(get_kp()->ws + WS_CTL) + CW_BAR; b_.x = xb_xcc_id(); b_.st = (volatile LAS unsigned*)(c.lds + LDS_BYTES - 16); int w_ = c.wave; asm volatile("" : "+s"(w_)); \
    unsigned m_ = ~0u; asm volatile("" : "+s"(m_)); xcd_barrier(b_, w_ == 0 && __builtin_amdgcn_mbcnt_hi(m_, __builtin_amdgcn_mbcnt_lo(m_, 0u)) == 0u); } while (0)
#ifndef REP_MASK
#define REP_MASK 0
#endif
#define REPD(bit, call) do { if ((REP_MASK >> (bit)) & 1) { int nrep_ = 2; asm volatile("" : "+s"(nrep_)); for (int r_ = 0; r_ < nrep_; ++r_) { if (r_) GRID_BAR(); const int dry_ = (r_ == 0); call; } } else { const int dry_ = 0; call; } } while (0)
#define REP(bit, stmt) do { if ((REP_MASK >> (bit)) & 1) { int nrep_ = 2; asm volatile("" : "+s"(nrep_)); for (int r_ = 0; r_ < nrep_; ++r_) { if (r_) GRID_BAR(); stmt; } } else { stmt; } } while (0)
    REP(0, prologue_phase(c)); REP(11, filters_phase(c));
    GRID_BAR();
    REP(1, kspec_phase(c));
    for (int l = 0; l < DEPTH; ++l) {
        if (l == 0) REP(12, norm_phase<0>(c, l)); else REPD(12, norm_phase<1>(c, l, dry_));
        GRID_BAR();
        REP(2, inproj_phase(c, l));
        GRID_BAR();
        REP(3, hyena_fft_phase(c, l)); __syncthreads(); REP(4, ret_sums_phase(c, l));
        GRID_BAR();
        REP(5, transpose_yhy_phase(c)); REP(10, ret_scan_phase(c, l));
        GRID_BAR();
        REP(6, ret_out_phase(c, l));
        GRID_BAR();
        REP(7, merge_phase(c, l));
        GRID_BAR();
        REPD(13, outproj_phase(c, l, dry_));
        GRID_BAR();
        REPD(14, normf_phase(c, l, dry_));
        GRID_BAR();
        REP(8, moe_gu_phase(c, l));
        GRID_BAR();
        REP(9, moe_down_phase(c, l));
        GRID_BAR();
    }
    norm_phase<3>(c, 0);
}

extern "C" void kernel_launch(void* const* d_in, const int* in_sizes, int n_in, void* d_out, int out_size, void* d_ws, size_t ws_size, hipStream_t stream) {
    static int grid = 0;
    if (grid == 0) {
        if (n_in != N_IN || in_sizes[0] != T * D || out_size != T * D || ws_size < WS_END) { fprintf(stderr, "kernel_launch: unexpected shapes (n_in %d, in0 %d, out %d, ws %zu < %zu)\n", n_in, n_in > 0 ? in_sizes[0] : -1, out_size, ws_size, (size_t)WS_END); grid = -1; return; }
        int dev = 0, cus = 0, per_cu = 0;
        if (hipGetDevice(&dev) != hipSuccess || hipDeviceGetAttribute(&cus, hipDeviceAttributeMultiprocessorCount, dev) != hipSuccess) { grid = -1; return; }
        if (hipFuncSetAttribute((const void*)k_mega, hipFuncAttributeMaxDynamicSharedMemorySize, LDS_BYTES) != hipSuccess) { fprintf(stderr, "kernel_launch: hipFuncSetAttribute failed\n"); grid = -1; return; }
        if (hipOccupancyMaxActiveBlocksPerMultiprocessor(&per_cu, (const void*)k_mega, NT, LDS_BYTES) != hipSuccess || per_cu < 1) fprintf(stderr, "kernel_launch: note: occupancy query reports %d workgroups per CU\n", per_cu);
        (void)hipGetLastError();
        grid = cus;
    }
    if (grid < 0) return;
    (void)hipMemsetAsync((char*)d_ws + WS_CTL, 0, CTL_BYTES, stream);
    Params p{};
    for (int i = 0; i < N_IN; ++i) p.in[i] = (const float*)d_in[i];
    p.out = (float*)d_out; p.ws = (unsigned char*)d_ws; p.phase = 0; p.layer = 0;
    hipLaunchKernelGGL(k_mega, dim3(grid), dim3(NT), LDS_BYTES, stream, p);
    const hipError_t e = hipPeekAtLastError(); if (e != hipSuccess) fprintf(stderr, "kernel_launch: launch failed: %s\n", hipGetErrorName(e));
}
```

```cpp
#include <hip/hip_runtime.h>
#include <cstdio>
#include <cstdint>

#define LAS __attribute__((address_space(3)))
typedef unsigned short bf16_t;
typedef short bf16x8 __attribute__((ext_vector_type(8)));
typedef float f32x4 __attribute__((ext_vector_type(4)));
typedef float f32x2 __attribute__((ext_vector_type(2)));
typedef unsigned u32x4 __attribute__((ext_vector_type(4)));
typedef unsigned u32x2 __attribute__((ext_vector_type(2)));

constexpr int D = 1024, NB = 4, S = 8192, T = NB * S, DEPTH = 4;
constexpr int NE = 32, CAP = 32768, FF = 1024;
constexpr int INC = 5120;
constexpr int P1R = 2048, P2C = 3072;
constexpr int NSLOT = T * 4 + NE * 256;
constexpr float EPS = 1e-6f;
constexpr int NT = 512;
constexpr int LDS_BYTES = 163840;
constexpr int LDS_TAB = 131072;

enum { I_X = 0, I_C, I_NMG, I_NFG, I_WMOD, I_BMOD, I_WIN, I_CW, I_CB, I_W1, I_B1, I_W2, I_B2, I_W3, I_B3, I_W4, I_FREQ, I_HBIAS,
       I_WHY, I_WRET, I_WOUT, I_WR, I_BR, I_WGU, I_BGU, I_WDN, I_BDN, I_FG, N_IN };

constexpr size_t MiB = 1u << 20;
constexpr size_t WS_CTL = 0, CTL_BYTES = 1 * MiB;
constexpr size_t WS_MOD = 1 * MiB;
constexpr size_t WS_ROPE = 2 * MiB;
constexpr size_t WS_L1P = 4 * MiB;
constexpr size_t WS_WIN1 = 12 * MiB;
constexpr size_t WS_WIN2 = 28 * MiB;
constexpr size_t WS_H8A = 2443 * MiB + 32 * MiB;
constexpr size_t WS_WHY = 52 * MiB;
constexpr size_t WS_WRET = 56 * MiB;
constexpr size_t WS_WOUT = 60 * MiB;
constexpr size_t WS_WGU = 68 * MiB;
constexpr size_t WS_WDN = 580 * MiB;
constexpr size_t WS_KT = 836 * MiB;
constexpr size_t WS_X = 1092 * MiB;
constexpr size_t WS_H = 1220 * MiB;
constexpr size_t WS_P1 = 1284 * MiB;
constexpr size_t WS_P2 = 1412 * MiB;
constexpr size_t WS_YHYT = 1604 * MiB;
constexpr size_t WS_YHY = 1636 * MiB;
constexpr size_t WS_YRET = 1668 * MiB;
constexpr size_t WS_M1 = 1700 * MiB;
constexpr size_t WS_MRG = 1764 * MiB;
constexpr size_t WS_TOKE = 1828 * MiB;
constexpr size_t WS_TOKG = 1829 * MiB;
constexpr size_t WS_TOKP = 1830 * MiB;
constexpr size_t WS_SLOT = 1831 * MiB;
constexpr size_t WS_ACT = 1835 * MiB;
constexpr size_t WS_YB = 2107 * MiB;
constexpr size_t WS_KVS = 2379 * MiB;
constexpr size_t WS_KVP = 2443 * MiB;
constexpr size_t WS_KF = 2507 * MiB;
constexpr size_t WS_G8 = 3019 * MiB;
constexpr size_t WS_END = 3083 * MiB;
constexpr int CW_BAR = 4096;
constexpr int CW_CNT = 16384;

struct Params { const float* in[N_IN]; float* out; unsigned char* ws; int phase; int layer; };

typedef __bf16 bf16x2_nat_ __attribute__((ext_vector_type(2)));
__device__ __forceinline__ unsigned pk2(float lo, float hi) { const bf16x2_nat_ v = {(__bf16)lo, (__bf16)hi}; return __builtin_bit_cast(unsigned, v); }
__device__ __forceinline__ unsigned f2bf(float f) { return pk2(f, 0.0f) & 0xffffu; }
__device__ __forceinline__ float bf_lo(unsigned w) { return __uint_as_float(w << 16); }
__device__ __forceinline__ float bf_hi(unsigned w) { return __uint_as_float(w & 0xffff0000u); }
__device__ __forceinline__ f32x4 bf4_to_f32(const u32x2 w) { return (f32x4){bf_lo(w.x), bf_hi(w.x), bf_lo(w.y), bf_hi(w.y)}; }
__device__ __forceinline__ float bf2f(bf16_t b) { return __uint_as_float(((unsigned)b) << 16); }
template <int M> __device__ __forceinline__ float swz_xor(float v) { return __int_as_float(__builtin_amdgcn_ds_swizzle(__float_as_int(v), (M << 10) | 0x1F)); }
template <int M> __device__ __forceinline__ int swz_xor_i(int v) { return __builtin_amdgcn_ds_swizzle(v, (M << 10) | 0x1F); }
__device__ __forceinline__ float xor32(float v, int lane) { return __int_as_float(__builtin_amdgcn_ds_bpermute((lane ^ 32) << 2, __float_as_int(v))); }
__device__ __forceinline__ int xor32_i(int v, int lane) { return __builtin_amdgcn_ds_bpermute((lane ^ 32) << 2, v); }
__device__ __forceinline__ float lane_prev(float v) { return __int_as_float(__builtin_amdgcn_update_dpp(0, __float_as_int(v), 0x138, 0xF, 0xF, true)); }
__device__ __forceinline__ float lane_next(float v) { return __int_as_float(__builtin_amdgcn_update_dpp(0, __float_as_int(v), 0x130, 0xF, 0xF, true)); }
template <int CTRL> __device__ __forceinline__ float dpp_f(float v) { return __int_as_float(__builtin_amdgcn_update_dpp(0, __float_as_int(v), CTRL, 0xF, 0xF, true)); }
template <int CTRL> __device__ __forceinline__ int dpp_i(int v) { return __builtin_amdgcn_update_dpp(0, v, CTRL, 0xF, 0xF, true); }
constexpr int DPP_X1 = 0xB1, DPP_X2 = 0x4E, DPP_HM = 0x141, DPP_RM = 0x140;
__device__ __forceinline__ float half_sum(float v) { v += dpp_f<DPP_X1>(v); v += dpp_f<DPP_X2>(v); v += dpp_f<DPP_HM>(v); v += dpp_f<DPP_RM>(v); v += swz_xor<16>(v); return v; }
__device__ __forceinline__ float wave_sum(float v, int lane) { v = half_sum(v); return v + xor32(v, lane); }
__device__ __forceinline__ float sigmoidf_(float x) { return __builtin_amdgcn_rcpf(1.0f + __builtin_amdgcn_exp2f(x * -1.4426950408889634f)); }
__device__ __forceinline__ float sigmoid_fast(float x) { return sigmoidf_(x); }
#define LDS_WAIT() asm volatile("s_waitcnt lgkmcnt(0)" ::: "memory")
#define VM_WAIT() asm volatile("s_waitcnt vmcnt(0)" ::: "memory")

struct Ctx {
    LAS unsigned char* lds;
    int tid, lane, wave, bid, G, vcu;
    unsigned char* ws;
};
typedef const __attribute__((address_space(4))) Params* KP;
__device__ __forceinline__ KP get_kp() { KP kp = (KP)__builtin_amdgcn_kernarg_segment_ptr(); asm volatile("" : "+s"(kp)); return kp; }
#define PH_ENTER() KP p = get_kp(); Ctx c; { int w_ = c0.wave; asm volatile("" : "+s"(w_)); unsigned m_ = ~0u; asm volatile("" : "+s"(m_)); int t_ = w_ * 64 + (int)__builtin_amdgcn_mbcnt_hi(m_, __builtin_amdgcn_mbcnt_lo(m_, 0u)); asm volatile("" : "+v"(t_)); \
    c.tid = t_; c.lane = t_ & 63; c.wave = w_; c.ws = p->ws; \
    unsigned lb_ = (unsigned)(uintptr_t)c0.lds; int b_ = c0.bid, g_ = c0.G; asm volatile("" : "+s"(lb_), "+s"(b_), "+s"(g_)); c.lds = (LAS unsigned char*)(uintptr_t)lb_; c.bid = b_; c.G = g_; \
    c.vcu = (g_ % 8 == 0) ? (b_ % 8) * (g_ / 8) + b_ / 8 : b_; }

#define XB_TMO      128
#define XB_XCNT(j)  (256  + 64 * (j))
#define XB_XSUB(j)  (1280 + 64 * (j))
#define XB_XGEN(j)  (2304 + 64 * (j))
#define XB_TOP      3328
#define XB_TOPGEN   3392
#define XCD_BAR_WORDS 3456
#define XB_SPIN_CAP (1u << 18)
__device__ __forceinline__ unsigned xb_ld(unsigned* p)              { return __hip_atomic_load(p, __ATOMIC_RELAXED, __HIP_MEMORY_SCOPE_AGENT); }
__device__ __forceinline__ unsigned xb_add(unsigned* p, unsigned v) { return __hip_atomic_fetch_add(p, v, __ATOMIC_RELAXED, __HIP_MEMORY_SCOPE_AGENT); }
__device__ __forceinline__ unsigned xb_xcc_id() { return (unsigned)__builtin_amdgcn_s_getreg((3 << 11) | 20) & 0xFu; }
#define XB_SPIN(cond, bar) do { unsigned _sp = 0; while (cond) { __builtin_amdgcn_s_sleep(1); \
    if ((++_sp & 255u) == 0u) { if (xb_ld(&(bar)[XB_TMO])) break; if (_sp > XB_SPIN_CAP) { atomicAdd(&(bar)[XB_TMO], 1u); break; } } } } while (0)
struct XcdBarrier { unsigned* bar; unsigned x; volatile LAS unsigned* st; };
__device__ __forceinline__ XcdBarrier xcd_barrier_post(unsigned* bar, volatile LAS unsigned* st) {
    XcdBarrier b; b.bar = bar; b.x = xb_xcc_id(); b.st = st;
    if (threadIdx.x == 0) (void)xb_add(&bar[XB_XCNT(b.x)], 1u);
    return b;
}
__device__ __forceinline__ void xcd_barrier_complete(unsigned* bar, unsigned x, unsigned& nloc, unsigned& nx) {
    const unsigned G = gridDim.x * gridDim.y * gridDim.z;
    unsigned sum, cnt, mine, sp = 0u;
    for (;;) {
        sum = 0u; cnt = 0u; mine = 0u;
#pragma unroll
        for (unsigned j = 0; j < 16; ++j) { const unsigned c = xb_ld(&bar[XB_XCNT(j)]); sum += c; cnt += (c > 0u) ? 1u : 0u; mine = (j == x) ? c : mine; }
        if (sum == G) break;
        __builtin_amdgcn_s_sleep(1);
        if ((++sp & 255u) == 0u) { if (xb_ld(&bar[XB_TMO])) break; if (sp > XB_SPIN_CAP) { atomicAdd(&bar[XB_TMO], 1u); break; } }
    }
    nloc = mine > 0u ? mine : 1u; nx = cnt > 0u ? cnt : 1u;
}
__device__ __forceinline__ void xcd_barrier(const XcdBarrier& b, const bool leader) {
    asm volatile("s_waitcnt vmcnt(0)" ::: "memory");
    __syncthreads();
    if (leader) {
        unsigned* bar = b.bar;
        __builtin_amdgcn_s_waitcnt(0);
        unsigned nloc = b.st[0], nx = b.st[1];
        if (nloc == 0u) { xcd_barrier_complete(bar, b.x, nloc, nx); b.st[0] = nloc; b.st[1] = nx; }
        const unsigned old = xb_add(&bar[XB_XSUB(b.x)], 1u);
        const unsigned gen = old / nloc;
        if (old + 1u == (gen + 1u) * nloc) {
            __builtin_amdgcn_fence(__ATOMIC_RELEASE, "agent");
            asm volatile("s_waitcnt vmcnt(0)" ::: "memory");
            const unsigned og = xb_add(&bar[XB_TOP], 1u);
            const unsigned tg = og / nx;
            if (og + 1u == (tg + 1u) * nx) xb_add(&bar[XB_TOPGEN], 1u);
            else XB_SPIN(xb_ld(&bar[XB_TOPGEN]) == tg, bar);
            __builtin_amdgcn_fence(__ATOMIC_ACQUIRE, "agent");
            xb_add(&bar[XB_XGEN(b.x)], 1u);
            asm volatile("s_waitcnt vmcnt(0)" ::: "memory");
        } else {
            XB_SPIN(xb_ld(&bar[XB_XGEN(b.x)]) == gen, bar);
            __builtin_amdgcn_fence(__ATOMIC_ACQUIRE, "agent");
            asm volatile("s_waitcnt vmcnt(0)" ::: "memory");
        }
    }
    __syncthreads();
}

namespace pg8 {
constexpr int BM = 256, BK = 64, HALF = 128, HTB = HALF * BK * 2, STAGE_BYTES = 8 * HTB, NXCD = 8, WGM = 8;
__host__ __device__ __forceinline__ int lds_byte(int r, int c) { const int st = (r >> 4) * 2 + (c >> 5), rr = r & 15, cc = c & 31, ob = rr * 64 + cc * 2; return st * 1024 + (ob ^ (((ob >> 9) & 1) << 5)); }
__host__ __device__ __forceinline__ void stage_rc(int b, int& R, int& C) { const int st = b / 1024, sb = b % 1024, swz = sb ^ (((sb >> 9) & 1) << 5); R = (st >> 1) * 16 + swz / 64; C = (st & 1) * 32 + (swz % 64) / 2; }
__host__ __device__ __forceinline__ int perm32(int rho) { const int n = rho >> 4, i = rho & 15; return 8 * (i >> 2) + 4 * n + (i & 3); }

struct Unit { int pm, pn, e; };
struct Gemm { const bf16_t* A; const bf16_t* Bt; int lda, ldb, K; size_t bstride; size_t astride = 0; };

struct StaticOrder {
    int nM, nN, nwg, G, c;
    __host__ __device__ void init(int M, int N, int G_, int c_) { nM = M / BM; nN = N / BM; nwg = nM * nN; G = G_; c = c_; }
    __host__ __device__ bool next(int i, Unit& u) const {
        const long L = (long)i * G + c; if (L >= nwg) return false;
        int wgid = (int)L; { const int q = nwg / NXCD, r = nwg % NXCD, xcd = wgid % NXCD, off = wgid / NXCD; wgid = (xcd < r ? xcd * (q + 1) : r * (q + 1) + (xcd - r) * q) + off; }
        const int nig = WGM * nN, gid = wgid / nig, fm = gid * WGM, gsz = (nM - fm) < WGM ? (nM - fm) : WGM;
        u.pm = fm + ((wgid % nig) % gsz); u.pn = (wgid % nig) / gsz; u.e = 0; return true;
    }
};
struct PairOrder : StaticOrder {
    __host__ __device__ bool next(int i, Unit& u) const { if (!StaticOrder::next(i >> 1, u)) return false; u.e = i & 1; return true; }
};
struct MoeOrder {
    int nM, nN, nwg, G, c; const LAS int* tile_e;
    __device__ void init(int nM_, int nN_, int G_, int c_, const LAS int* te) { nM = nM_; nN = nN_; nwg = nM * nN; G = G_; c = c_; tile_e = te; }
    __device__ bool next(int i, Unit& u) const {
        const long L = (long)i * G + c; if (L >= nwg) return false;
        int wgid = (int)L; { const int q = nwg / NXCD, r = nwg % NXCD, xcd = wgid % NXCD, off = wgid / NXCD; wgid = (xcd < r ? xcd * (q + 1) : r * (q + 1) + (xcd - r) * q) + off; }
        const int nig = WGM * nN, gid = wgid / nig, fm = gid * WGM, gsz = (nM - fm) < WGM ? (nM - fm) : WGM;
        u.pm = fm + ((wgid % nig) % gsz); u.pn = (wgid % nig) / gsz; u.e = tile_e[u.pm]; return true;
    }
};

typedef __bf16 bf16x2_native __attribute__((ext_vector_type(2)));
__device__ __forceinline__ unsigned cvt_pk_bf16(float lo, float hi) { const bf16x2_native v = {(__bf16)lo, (__bf16)hi}; return __builtin_bit_cast(unsigned, v); }

typedef int i32x4_t __attribute__((ext_vector_type(4)));
typedef int i32x8_t __attribute__((ext_vector_type(8)));
__device__ __forceinline__ i32x8_t cat8(const bf16x8 a, const bf16x8 b) { return __builtin_shufflevector(__builtin_bit_cast(i32x4_t, a), __builtin_bit_cast(i32x4_t, b), 0, 1, 2, 3, 4, 5, 6, 7); }
template <class Epi, class Sched, bool GATHER, bool F8 = false>
__device__ __forceinline__ void gemm_phase(LAS unsigned char* lds, const Gemm g, const Sched& S, const Epi& E, const LAS int* rowtab, const int tid) {
    const int wid = __builtin_amdgcn_readfirstlane(tid >> 6), lane = tid & 63, wr = wid >> 2, wc = wid & 3, fr = lane & 15, fq = lane >> 4;
    const int K = g.K, nt = K / BK;
    unsigned voffB[2], voffA[2][2], go[2] = {0u, 0u}; int gRC = 0;
#pragma unroll
    for (int i = 0; i < 2; ++i) { int R, C; stage_rc(tid * 16 + i * 8192, R, C); const int Rb = Epi::PERM ? ((R & ~31) + perm32(R & 31)) : R;
        voffB[i] = (unsigned)(Rb * g.ldb + C) * 2u;
#pragma unroll
        for (int h = 0; h < 2; ++h) voffA[h][i] = (unsigned)((h * HALF + R) * g.lda + C) * 2u; if (i == 0) gRC = R | (C << 8); }
    const size_t kstep = (size_t)(BK * 2);
    const size_t hstepB = (size_t)HALF * g.ldb * 2; const unsigned hstepA32 = (unsigned)(HALF * g.lda * 2);
    const size_t tstepA = (size_t)BM * g.lda * 2, tstepB = (size_t)BM * g.ldb * 2;
    const unsigned ldsw = (unsigned)wid * 1024u;
    const int aoff = lds_byte(wr * 64 + fr, fq * 8), boff = lds_byte(wc * 32 + fr, fq * 8);
#define PG8_SA(b, h) (((b) * 2 + (h)) * HTB)
#define PG8_SB(b, h) ((4 + (b) * 2 + (h)) * HTB)
#define PG8_STAGE_B(bufoff, gbase, h) do { _Pragma("unroll") for (int _i = 0; _i < 2; ++_i) { unsigned _o = voffB[_i]; asm volatile("" : "+v"(_o)); \
        __builtin_amdgcn_global_load_lds((const unsigned*)((const char*)(gbase) + (h) * hstepB + _o), (LAS unsigned*)(lds + (bufoff) + ldsw + _i * 8192), 16, 0, 0); } } while (0)
#define PG8_STAGE_A(bufoff, gbase, h) do { _Pragma("unroll") for (int _i = 0; _i < 2; ++_i) { unsigned _o = GATHER ? go[_i] : voffA[0][_i]; asm volatile("" : "+v"(_o)); if (!GATHER) _o += (unsigned)(h) * hstepA32; \
        __builtin_amdgcn_global_load_lds((const unsigned*)((const char*)(gbase) + _o), (LAS unsigned*)(lds + (bufoff) + ldsw + _i * 8192), 16, 0, 0); } } while (0)
#define PG8_LDA(dst, b, h) do { _Pragma("unroll") for (int m = 0; m < 4; ++m) dst[m] = __builtin_shufflevector(*(const LAS i32x4_t*)(lds + PG8_SA(b, h) + aoff + m * 2048), *(const LAS i32x4_t*)(lds + PG8_SA(b, h) + aoff + m * 2048 + 1024), 0, 1, 2, 3, 4, 5, 6, 7); } while (0)
#define PG8_LDB(dst, b, h) do { _Pragma("unroll") for (int n = 0; n < 2; ++n) dst[n] = __builtin_shufflevector(*(const LAS i32x4_t*)(lds + PG8_SB(b, h) + boff + n * 2048), *(const LAS i32x4_t*)(lds + PG8_SB(b, h) + boff + n * 2048 + 1024), 0, 1, 2, 3, 4, 5, 6, 7); } while (0)
#define PG8_LO(v) __builtin_bit_cast(bf16x8, __builtin_shufflevector(v, v, 0, 1, 2, 3))
#define PG8_HI(v) __builtin_bit_cast(bf16x8, __builtin_shufflevector(v, v, 4, 5, 6, 7))
#define PG8_MMA(ai, bj, At, Bt) do { __builtin_amdgcn_s_setprio(1); if constexpr (F8) { _Pragma("unroll") for (int m = 0; m < 4; ++m) _Pragma("unroll") for (int n = 0; n < 2; ++n) \
        acc[ai][bj][m][n] = __builtin_amdgcn_mfma_scale_f32_16x16x128_f8f6f4(Bt[n], At[m], acc[ai][bj][m][n], 0, 0, 0, 0, 0, 0); } else { \
        _Pragma("unroll") for (int m = 0; m < 4; ++m) _Pragma("unroll") for (int n = 0; n < 2; ++n) { \
        acc[ai][bj][m][n] = __builtin_amdgcn_mfma_f32_16x16x32_bf16(PG8_LO(Bt[n]), PG8_LO(At[m]), acc[ai][bj][m][n], 0, 0, 0); \
        acc[ai][bj][m][n] = __builtin_amdgcn_mfma_f32_16x16x32_bf16(PG8_HI(Bt[n]), PG8_HI(At[m]), acc[ai][bj][m][n], 0, 0, 0); } } __builtin_amdgcn_s_setprio(0); } while (0)
#define PG8_WAIT_V(n) asm volatile("s_waitcnt vmcnt(" #n ")" ::: "memory")
#define PG8_WAIT_L(n) asm volatile("s_waitcnt lgkmcnt(" #n ")" ::: "memory")
#define PG8_BAR __builtin_amdgcn_s_barrier()
#define PG8_SCHED __builtin_amdgcn_sched_barrier(0)
#define PG8_GO(un_, h_) do { if constexpr (GATHER) { _Pragma("unroll") for (int _i = 0; _i < 2; ++_i) go[_i] = (unsigned)(rowtab[(un_) * BM + (h_) * HALF + (gRC & 255) + 64 * _i] * g.lda + (gRC >> 8)) * 2u; } } while (0)
    Unit cur, nxt; int ui = 0;
    if (!S.next(0, cur)) return;
    f32x4 acc[2][2][4][2];
#pragma unroll
    for (int a = 0; a < 2; ++a)
#pragma unroll
        for (int b = 0; b < 2; ++b)
#pragma unroll
            for (int m = 0; m < 4; ++m)
#pragma unroll
                for (int n = 0; n < 2; ++n) acc[a][b][m][n] = (f32x4){0.f, 0.f, 0.f, 0.f};
    i32x8_t At[4], B0[2], B1[2];
    const char* cA = (const char*)g.A + (GATHER ? (size_t)0 : (size_t)cur.e * g.astride * 2 + (size_t)cur.pm * tstepA);
    const char* cB = (const char*)g.Bt + (size_t)cur.e * g.bstride * 2 + (size_t)cur.pn * tstepB;
    PG8_STAGE_B(PG8_SB(0, 0), cB, 0); PG8_STAGE_B(PG8_SB(0, 1), cB, 1); PG8_GO(0, 0); PG8_STAGE_A(PG8_SA(0, 0), cA, 0); PG8_GO(0, 1); PG8_STAGE_A(PG8_SA(0, 1), cA, 1);
    if (wr == 1) PG8_BAR;
    PG8_WAIT_V(2); PG8_BAR;
    PG8_STAGE_B(PG8_SB(1, 0), cB + kstep, 0); PG8_GO(0, 0); PG8_STAGE_A(PG8_SA(1, 0), cA + kstep, 0); PG8_STAGE_B(PG8_SB(1, 1), cB + kstep, 1);
    PG8_WAIT_V(6); PG8_BAR;
    for (;;) {
        const bool has_next = S.next(ui + 1, nxt);
        const char* nA = has_next ? (const char*)g.A + (GATHER ? (size_t)0 : (size_t)nxt.e * g.astride * 2 + (size_t)nxt.pm * tstepA) : cA;
        const char* nB = has_next ? (const char*)g.Bt + (size_t)nxt.e * g.bstride * 2 + (size_t)nxt.pn * tstepB : cB;
#pragma unroll 1
        for (int t = 0; t < nt; t += 2) {
            const bool last = (t == nt - 2);
            const int un = (last && has_next) ? ui + 1 : ui;
            const char* a1 = cA + (size_t)(t + 1) * kstep;
            const char* a2 = last ? nA : cA + (size_t)(t + 2) * kstep; const char* b2 = last ? nB : cB + (size_t)(t + 2) * kstep;
            const char* a3 = a2 + kstep; const char* b3 = b2 + kstep;
            PG8_GO(ui, 1); PG8_LDB(B0, 0, 0); PG8_LDB(B1, 0, 1); PG8_SCHED; PG8_LDA(At, 0, 0); PG8_STAGE_A(PG8_SA(1, 1), a1, 1);
            PG8_WAIT_V(8); PG8_WAIT_L(0); PG8_BAR; PG8_MMA(0, 0, At, B0); PG8_MMA(0, 1, At, B1); PG8_BAR; PG8_SCHED;
            PG8_GO(un, 0); PG8_LDA(At, 0, 1); PG8_STAGE_B(PG8_SB(0, 0), b2, 0); PG8_STAGE_B(PG8_SB(0, 1), b2, 1); PG8_STAGE_A(PG8_SA(0, 0), a2, 0);
            PG8_WAIT_V(8); PG8_WAIT_L(0); PG8_BAR; PG8_MMA(1, 0, At, B0); PG8_MMA(1, 1, At, B1); PG8_BAR; PG8_SCHED;
            PG8_GO(un, 1); PG8_LDB(B0, 1, 0); PG8_LDB(B1, 1, 1); PG8_SCHED; PG8_LDA(At, 1, 0); PG8_STAGE_A(PG8_SA(0, 1), a2, 1);
            PG8_WAIT_V(8); PG8_WAIT_L(0); PG8_BAR; PG8_MMA(0, 0, At, B0); PG8_MMA(0, 1, At, B1); PG8_BAR; PG8_SCHED;
            PG8_GO(un, 0); PG8_LDA(At, 1, 1); PG8_STAGE_B(PG8_SB(1, 0), b3, 0); PG8_STAGE_B(PG8_SB(1, 1), b3, 1); PG8_STAGE_A(PG8_SA(1, 0), a3, 0);
            PG8_WAIT_V(8); PG8_WAIT_L(0); PG8_BAR; PG8_MMA(1, 0, At, B0); PG8_MMA(1, 1, At, B1); PG8_BAR; PG8_SCHED;
        }
        if (wr == 0) PG8_BAR;
        { unsigned me_ = ~0u; asm volatile("" : "+s"(me_)); const int te_ = (int)__builtin_amdgcn_mbcnt_hi(me_, __builtin_amdgcn_mbcnt_lo(me_, 0u));
          E(acc, cur, wr, wc, te_ & 15, (te_ & 63) >> 4); }
        if (!has_next) break;
        if (!(Epi::CHAIN && cur.e == 0)) {
#pragma unroll
        for (int a = 0; a < 2; ++a)
#pragma unroll
            for (int b = 0; b < 2; ++b)
#pragma unroll
                for (int m = 0; m < 4; ++m)
#pragma unroll
                    for (int n = 0; n < 2; ++n) acc[a][b][m][n] = (f32x4){0.f, 0.f, 0.f, 0.f}; }
        cur = nxt; cA = nA; cB = nB; ++ui;
        if (wr == 1) PG8_BAR;
    }
    PG8_WAIT_V(0);
    PG8_BAR;
#undef PG8_SA
#undef PG8_SB
#undef PG8_STAGE_A
#undef PG8_STAGE_B
#undef PG8_LDA
#undef PG8_LDB
#undef PG8_MMA
#undef PG8_WAIT_V
#undef PG8_WAIT_L
#undef PG8_BAR
#undef PG8_SCHED
#undef PG8_GO
}
}
namespace pg8 {
#define EPI_ROW(u, ai, m) ((u).pm * BM + (ai) * HALF + wr * 64 + (m) * 16 + fr)
#define EPI_COL8(u, bj) ((u).pn * BM + (bj) * HALF + wc * 32 + 8 * fq)
#define EPI_COL4(u, bj, n) ((u).pn * BM + (bj) * HALF + wc * 32 + 16 * (n) + 4 * fq)
__device__ __forceinline__ u32x4 pack8(const f32x4 v0, const f32x4 v1) { u32x4 w; w.x = cvt_pk_bf16(v0[0], v0[1]); w.y = cvt_pk_bf16(v0[2], v0[3]); w.z = cvt_pk_bf16(v1[0], v1[1]); w.w = cvt_pk_bf16(v1[2], v1[3]); return w; }
__device__ __forceinline__ void unpack8(const u32x4 w, f32x4& v0, f32x4& v1) { v0 = (f32x4){bf_lo(w.x), bf_hi(w.x), bf_lo(w.y), bf_hi(w.y)}; v1 = (f32x4){bf_lo(w.z), bf_hi(w.z), bf_lo(w.w), bf_hi(w.w)}; }

struct EpiPlain {
    static constexpr bool PERM = true, CHAIN = false;
    bf16_t* O; int ldc; float sc;
    __device__ __forceinline__ void operator()(const f32x4 (&acc)[2][2][4][2], const Unit& u, int wr, int wc, int fr, int fq) const {
#pragma unroll
        for (int ai = 0; ai < 2; ++ai)
#pragma unroll
            for (int m = 0; m < 4; ++m) { bf16_t* rowp = O + (size_t)EPI_ROW(u, ai, m) * ldc;
#pragma unroll
                for (int bj = 0; bj < 2; ++bj) *(u32x4*)(rowp + EPI_COL8(u, bj)) = pack8(acc[ai][bj][m][0] * sc, acc[ai][bj][m][1] * sc); }
    }
};
#ifdef NULL_PROBE
struct EpiNull {
    static constexpr bool PERM = true, CHAIN = false;
    __device__ __forceinline__ void operator()(const f32x4 (&acc)[2][2][4][2], const Unit& u, int wr, int wc, int fr, int fq) const {
#pragma unroll
        for (int ai = 0; ai < 2; ++ai)
#pragma unroll
            for (int bj = 0; bj < 2; ++bj)
#pragma unroll
                for (int m = 0; m < 4; ++m) { asm volatile("" :: "v"(acc[ai][bj][m][0]), "v"(acc[ai][bj][m][1])); }
    }
};
#endif
__device__ __forceinline__ unsigned pk4_u8(const f32x4 g) { unsigned w = 0;
    w = __builtin_amdgcn_cvt_pk_u8_f32(g[0] * 256.0f - 0.5f, 0, w); w = __builtin_amdgcn_cvt_pk_u8_f32(g[1] * 256.0f - 0.5f, 1, w);
    w = __builtin_amdgcn_cvt_pk_u8_f32(g[2] * 256.0f - 0.5f, 2, w); w = __builtin_amdgcn_cvt_pk_u8_f32(g[3] * 256.0f - 0.5f, 3, w); return w; }
__device__ __forceinline__ f32x4 unpk4_u8(const unsigned w) { const f32x4 q = {(float)(w & 255u), (float)((w >> 8) & 255u), (float)((w >> 16) & 255u), (float)(w >> 24)}; return q * (1.0f / 256.0f) + (0.5f / 256.0f); }
struct EpiP2 {
    static constexpr bool PERM = true, CHAIN = false;
    bf16_t* O; const float* rope; float sc;
    __device__ __forceinline__ void operator()(const f32x4 (&acc)[2][2][4][2], const Unit& u, int wr, int wc, int fr, int fq) const {
        if (u.pn < 2) {
            const float ksc = (u.pn == 1 ? 0.125f : 1.0f) * sc; const int i0 = ((wc * 32 + 8 * fq) & 63) >> 1;
#pragma unroll
            for (int ai = 0; ai < 2; ++ai) { f32x4 r[4][2];
#pragma unroll
                for (int m = 0; m < 4; ++m) { const int pos = EPI_ROW(u, ai, m) & (S - 1); const f32x4* rp = (const f32x4*)(rope + ((size_t)pos * 32 + i0) * 2); r[m][0] = rp[0]; r[m][1] = rp[1]; }
#pragma unroll
                for (int m = 0; m < 4; ++m) { bf16_t* rowp = O + (size_t)EPI_ROW(u, ai, m) * P2C; const f32x4 r0 = r[m][0], r1 = r[m][1];
#pragma unroll
                    for (int bj = 0; bj < 2; ++bj) { const f32x4 v0 = acc[ai][bj][m][0], v1 = acc[ai][bj][m][1]; f32x4 o0, o1;
                        o0[0] = (v0[0] * r0[0] - v0[1] * r0[1]) * ksc; o0[1] = (v0[1] * r0[0] + v0[0] * r0[1]) * ksc;
                        o0[2] = (v0[2] * r0[2] - v0[3] * r0[3]) * ksc; o0[3] = (v0[3] * r0[2] + v0[2] * r0[3]) * ksc;
                        o1[0] = (v1[0] * r1[0] - v1[1] * r1[1]) * ksc; o1[1] = (v1[1] * r1[0] + v1[0] * r1[1]) * ksc;
                        o1[2] = (v1[2] * r1[2] - v1[3] * r1[3]) * ksc; o1[3] = (v1[3] * r1[2] + v1[2] * r1[3]) * ksc;
                        *(u32x4*)(rowp + EPI_COL8(u, bj)) = pack8(o0, o1); } } }
        } else if (u.pn < 4) {
#pragma unroll
            for (int ai = 0; ai < 2; ++ai)
#pragma unroll
                for (int m = 0; m < 4; ++m) { bf16_t* rowp = O + (size_t)EPI_ROW(u, ai, m) * P2C;
#pragma unroll
                    for (int bj = 0; bj < 2; ++bj) *(u32x4*)(rowp + EPI_COL8(u, bj)) = pack8(acc[ai][bj][m][0] * sc, acc[ai][bj][m][1] * sc); }
        } else { unsigned char* G8 = get_kp()->ws + WS_G8;
#pragma unroll
            for (int ai = 0; ai < 2; ++ai)
#pragma unroll
                for (int m = 0; m < 4; ++m) { unsigned char* rowp = G8 + (size_t)EPI_ROW(u, ai, m) * 2048 - 1024;
#pragma unroll
                    for (int bj = 0; bj < 2; ++bj) { f32x4 v0 = acc[ai][bj][m][0] * sc, v1 = acc[ai][bj][m][1] * sc;
#pragma unroll
                        for (int j = 0; j < 4; ++j) { v0[j] = sigmoidf_(v0[j]); v1[j] = sigmoidf_(v1[j]); }
                        u32x2 w8; w8.x = pk4_u8(v0); w8.y = pk4_u8(v1); *(u32x2*)(rowp + EPI_COL8(u, bj)) = w8; } }
        }
    }
};
struct EpiGate8 {
    static constexpr bool PERM = true, CHAIN = false;
    bf16_t* O;
    __device__ __forceinline__ void operator()(const f32x4 (&acc)[2][2][4][2], const Unit& u, int wr, int wc, int fr, int fq) const {
#pragma unroll
        for (int ai = 0; ai < 2; ++ai)
#pragma unroll
            for (int m = 0; m < 4; ++m) { bf16_t* rowp = O + (size_t)EPI_ROW(u, ai, m) * P2C + 1024;
#pragma unroll
                for (int bj = 0; bj < 2; ++bj) { f32x4 v0 = acc[ai][bj][m][0] * 0.03125f, v1 = acc[ai][bj][m][1] * 0.03125f;
#pragma unroll
                    for (int j = 0; j < 4; ++j) { v0[j] = sigmoid_fast(v0[j]); v1[j] = sigmoid_fast(v1[j]); }
                    *(u32x4*)(rowp + EPI_COL8(u, bj)) = pack8(v0, v1); } }
    }
};
struct EpiHy {
    static constexpr bool PERM = true, CHAIN = false;
    bf16_t* M1; const bf16_t* P2;
    __device__ __forceinline__ void operator()(const f32x4 (&acc)[2][2][4][2], const Unit& u, int wr, int wc, int fr, int fq) const {
#pragma unroll
        for (int ai = 0; ai < 2; ++ai)
#pragma unroll
            for (int m = 0; m < 4; ++m) { const int row = EPI_ROW(u, ai, m);
#pragma unroll
                for (int bj = 0; bj < 2; ++bj) { const int col = EPI_COL8(u, bj); f32x4 g0, g1; unpack8(*(const u32x4*)(P2 + (size_t)row * P2C + 1024 + col), g0, g1);
                    *(u32x4*)(M1 + (size_t)row * D + col) = pack8(acc[ai][bj][m][0] * g0, acc[ai][bj][m][1] * g1); } }
    }
};
struct EpiRet {
    static constexpr bool PERM = true, CHAIN = false;
    bf16_t* MRG; const bf16_t* M1; const bf16_t* P2;
    __device__ __forceinline__ void operator()(const f32x4 (&acc)[2][2][4][2], const Unit& u, int wr, int wc, int fr, int fq) const {
#pragma unroll
        for (int ai = 0; ai < 2; ++ai)
#pragma unroll
            for (int m = 0; m < 4; ++m) { const int row = EPI_ROW(u, ai, m);
#pragma unroll
                for (int bj = 0; bj < 2; ++bj) { const int col = EPI_COL8(u, bj); f32x4 g0, g1, a0, a1; unpack8(*(const u32x4*)(P2 + (size_t)row * P2C + 2048 + col), g0, g1);
                    unpack8(*(const u32x4*)(M1 + (size_t)row * D + col), a0, a1);
                    *(u32x4*)(MRG + (size_t)row * D + col) = pack8(a0 + acc[ai][bj][m][0] * g0, a1 + acc[ai][bj][m][1] * g1); } }
    }
};
struct EpiMerge {
    static constexpr bool PERM = true, CHAIN = true;
    bf16_t* MRG;
    __device__ __forceinline__ void operator()(f32x4 (&acc)[2][2][4][2], const Unit& u, int wr, int wc, int fr, int fq) const { const unsigned char* G8 = get_kp()->ws + WS_G8;
#pragma unroll
        for (int ai = 0; ai < 2; ++ai) { u32x2 rw[4][2];
#pragma unroll
            for (int m = 0; m < 4; ++m)
#pragma unroll
                for (int bj = 0; bj < 2; ++bj) rw[m][bj] = *(const u32x2*)(G8 + (size_t)EPI_ROW(u, ai, m) * 2048 + 1024 + EPI_COL8(u, bj));
            if (u.e == 0) { u32x2 hw[4][2];
#pragma unroll
                for (int m = 0; m < 4; ++m)
#pragma unroll
                    for (int bj = 0; bj < 2; ++bj) hw[m][bj] = *(const u32x2*)(G8 + (size_t)EPI_ROW(u, ai, m) * 2048 + EPI_COL8(u, bj));
#pragma unroll
                for (int m = 0; m < 4; ++m)
#pragma unroll
                    for (int bj = 0; bj < 2; ++bj) { const f32x4 r0 = unpk4_u8(rw[m][bj].x), r1 = unpk4_u8(rw[m][bj].y), h0 = unpk4_u8(hw[m][bj].x), h1 = unpk4_u8(hw[m][bj].y);
#pragma unroll
                        for (int j = 0; j < 4; ++j) { acc[ai][bj][m][0][j] *= h0[j] * __builtin_amdgcn_rcpf(r0[j]); acc[ai][bj][m][1][j] *= h1[j] * __builtin_amdgcn_rcpf(r1[j]); } }
            } else {
#pragma unroll
                for (int m = 0; m < 4; ++m)
#pragma unroll
                    for (int bj = 0; bj < 2; ++bj) *(u32x4*)(MRG + (size_t)EPI_ROW(u, ai, m) * D + EPI_COL8(u, bj)) = pack8(acc[ai][bj][m][0] * unpk4_u8(rw[m][bj].x), acc[ai][bj][m][1] * unpk4_u8(rw[m][bj].y));
            }
        }
    }
};
struct EpiOut {
    static constexpr bool PERM = true, CHAIN = false;
    bf16_t* X; const float* Xin32; const bf16_t* Xin16; const float* ga;
    __device__ __forceinline__ void operator()(const f32x4 (&acc)[2][2][4][2], const Unit& u, int wr, int wc, int fr, int fq) const {
        const int b = (u.pm * BM) >> 13;
        f32x4 g[2][2];
#pragma unroll
        for (int bj = 0; bj < 2; ++bj) { const int col = EPI_COL8(u, bj); g[bj][0] = *(const f32x4*)(ga + b * 6144 + col); g[bj][1] = *(const f32x4*)(ga + b * 6144 + col + 4); }
#pragma unroll
        for (int ai = 0; ai < 2; ++ai) {
            if (Xin32) { f32x4 x[4][2][2];
#pragma unroll
                for (int m = 0; m < 4; ++m)
#pragma unroll
                    for (int bj = 0; bj < 2; ++bj) { const float* xp = Xin32 + (size_t)EPI_ROW(u, ai, m) * D + EPI_COL8(u, bj); x[m][bj][0] = *(const f32x4*)xp; x[m][bj][1] = *(const f32x4*)(xp + 4); }
#pragma unroll
                for (int m = 0; m < 4; ++m)
#pragma unroll
                    for (int bj = 0; bj < 2; ++bj) *(u32x4*)(X + (size_t)EPI_ROW(u, ai, m) * D + EPI_COL8(u, bj)) = pack8(x[m][bj][0] + g[bj][0] * acc[ai][bj][m][0], x[m][bj][1] + g[bj][1] * acc[ai][bj][m][1]);
            } else { u32x4 xw[4][2];
#pragma unroll
                for (int m = 0; m < 4; ++m)
#pragma unroll
                    for (int bj = 0; bj < 2; ++bj) xw[m][bj] = *(const u32x4*)(Xin16 + (size_t)EPI_ROW(u, ai, m) * D + EPI_COL8(u, bj));
#pragma unroll
                for (int m = 0; m < 4; ++m)
#pragma unroll
                    for (int bj = 0; bj < 2; ++bj) { f32x4 x0, x1; unpack8(xw[m][bj], x0, x1);
                        *(u32x4*)(X + (size_t)EPI_ROW(u, ai, m) * D + EPI_COL8(u, bj)) = pack8(x0 + g[bj][0] * acc[ai][bj][m][0], x1 + g[bj][1] * acc[ai][bj][m][1]); }
            }
        }
    }
};
struct EpiGU {
    static constexpr bool PERM = true, CHAIN = false;
    bf16_t* ACT; const float* bias;
    __device__ __forceinline__ void operator()(const f32x4 (&acc)[2][2][4][2], const Unit& u, int wr, int wc, int fr, int fq) const {
        const float* be = bias + (size_t)u.e * 2048;
#pragma unroll
        for (int bj = 0; bj < 2; ++bj) { const int col = EPI_COL8(u, bj); const f32x4 b0 = *(const f32x4*)(be + col), b1 = *(const f32x4*)(be + col + 4);
#pragma unroll
            for (int ai = 0; ai < 2; ++ai)
#pragma unroll
                for (int m = 0; m < 4; ++m) { const int row = EPI_ROW(u, ai, m); const f32x4 v0 = acc[ai][bj][m][0] + b0, v1 = acc[ai][bj][m][1] + b1; float a[4];
#pragma unroll
                    for (int j = 0; j < 4; ++j) { const float gt = fminf(j < 2 ? v0[2 * j] : v1[2 * j - 4], 7.0f); float up = j < 2 ? v0[2 * j + 1] : v1[2 * j - 3]; up = fminf(fmaxf(up, -7.0f), 7.0f);
                        a[j] = (up + 1.0f) * (gt * sigmoidf_(1.702f * gt)); }
                    u32x2 w; w.x = cvt_pk_bf16(a[0], a[1]); w.y = cvt_pk_bf16(a[2], a[3]);
                    *(u32x2*)(ACT + (size_t)row * FF + (col >> 1)) = w; } }
    }
};
__device__ __forceinline__ unsigned pk4_fp8(float a, float b, float c, float d) { int w = 0; w = __builtin_amdgcn_cvt_pk_fp8_f32(a, b, w, false); w = __builtin_amdgcn_cvt_pk_fp8_f32(c, d, w, true); return (unsigned)w; }
struct EpiGU8 {
    static constexpr bool PERM = true, CHAIN = false;
    int l;
    __device__ __forceinline__ void operator()(const f32x4 (&acc)[2][2][4][2], const Unit& u, int wr, int wc, int fr, int fq) const {
        const KP kp_ = get_kp(); unsigned char* ACT8 = kp_->ws + WS_ACT; const float* bias = kp_->in[I_BGU] + (size_t)l * NE * 2048;
        const int f0 = u.pn * 128 + wc * 32 + 8 * fq; const float* be = bias + (size_t)u.e * 2048 + 2 * f0;
        const f32x4 q0 = *(const f32x4*)(be), q1 = *(const f32x4*)(be + 4), q2 = *(const f32x4*)(be + 8), q3 = *(const f32x4*)(be + 12);
        const float bg[8] = {q0[0], q0[2], q1[0], q1[2], q2[0], q2[2], q3[0], q3[2]}, bu[8] = {q0[1], q0[3], q1[1], q1[3], q2[1], q2[3], q3[1], q3[3]};
#pragma unroll
        for (int ai = 0; ai < 2; ++ai)
#pragma unroll
            for (int m = 0; m < 4; ++m) { const int row = EPI_ROW(u, ai, m); float a[8];
#pragma unroll
                for (int j = 0; j < 8; ++j) { const float gt = fminf(acc[ai][0][m][j >> 2][j & 3] * 0.03125f + bg[j], 7.0f); const float up = fminf(fmaxf(acc[ai][1][m][j >> 2][j & 3] * 0.03125f + bu[j], -7.0f), 7.0f);
                    a[j] = (up + 1.0f) * (gt * sigmoid_fast(1.702f * gt)); }
                u32x2 w; w.x = pk4_fp8(a[0], a[1], a[2], a[3]); w.y = pk4_fp8(a[4], a[5], a[6], a[7]);
                *(u32x2*)(ACT8 + (size_t)row * FF + f0) = w; }
    }
};
struct EpiDown {
    static constexpr bool PERM = true, CHAIN = false;
    int l; float sc;
    __device__ __forceinline__ void operator()(const f32x4 (&acc)[2][2][4][2], const Unit& u, int wr, int wc, int fr, int fq) const {
        const KP kp_ = get_kp(); bf16_t* YB = (bf16_t*)(kp_->ws + WS_YB); const float* bias = kp_->in[I_BDN] + (size_t)l * NE * D;
        const float* be = bias + (size_t)u.e * 1024; f32x4 bb[2][2];
#pragma unroll
        for (int bj = 0; bj < 2; ++bj) { bb[bj][0] = *(const f32x4*)(be + EPI_COL8(u, bj)); bb[bj][1] = *(const f32x4*)(be + EPI_COL8(u, bj) + 4); }
#pragma unroll
        for (int bj = 0; bj < 2; ++bj) { const int col = EPI_COL8(u, bj); const f32x4 b0 = bb[bj][0], b1 = bb[bj][1];
#pragma unroll
            for (int ai = 0; ai < 2; ++ai)
#pragma unroll
                for (int m = 0; m < 4; ++m) { const int row = EPI_ROW(u, ai, m);
                    { const f32x4 y0 = acc[ai][bj][m][0] * sc + b0, y1 = acc[ai][bj][m][1] * sc + b1; u32x2 w8; w8.x = pk4_fp8(y0[0], y0[1], y0[2], y0[3]); w8.y = pk4_fp8(y1[0], y1[1], y1[2], y1[3]);
                      *(u32x2*)((unsigned char*)YB + (size_t)row * D + col) = w8; } } }
    }
};
}
__device__ __forceinline__ void titem_load(f32x4 (&r)[8], const float* src, int N, int lane) {
#pragma unroll
    for (int i = 0; i < 8; ++i) r[i] = *(const f32x4*)(src + (size_t)(8 * i + (lane >> 3)) * N + (lane & 7) * 4);
}
__device__ __forceinline__ void titem_to_lds(const f32x4 (&r)[8], LAS float* scr, int lane) {
#pragma unroll
    for (int i = 0; i < 8; ++i) *(LAS f32x4*)(scr + (8 * i + (lane >> 3)) * 36 + (lane & 7) * 4) = r[i];
    LDS_WAIT(); asm volatile("" ::: "memory");
}
template <class RowPtr>
__device__ __forceinline__ void titem_store_bf16(LAS float* scr, int lane, int k0, int n0, const RowPtr& rp) {
    const int c = lane & 7;
#pragma unroll
    for (int j = 0; j < 4; ++j) { const int n = (lane >> 3) + 8 * j; const LAS float* s = scr + (8 * c) * 36 + n;
        u32x4 o; o.x = pk2(s[0 * 36], s[1 * 36]); o.y = pk2(s[2 * 36], s[3 * 36]); o.z = pk2(s[4 * 36], s[5 * 36]); o.w = pk2(s[6 * 36], s[7 * 36]);
        *(u32x4*)(rp(n0 + n) + k0 + 8 * c) = o; }
    LDS_WAIT(); asm volatile("" ::: "memory");
}
template <class RowPtr8>
__device__ __forceinline__ void titem_store_fp8(LAS float* scr, int lane, int k0, int n0, const RowPtr8& rp, float scale) {
#pragma unroll
    for (int j = 0; j < 2; ++j) { const int task = lane + 64 * j, n = task >> 2, kc = task & 3; const LAS float* s = scr + (16 * kc) * 36 + n; u32x4 o;
        o.x = pg8::pk4_fp8(s[0 * 36] * scale, s[1 * 36] * scale, s[2 * 36] * scale, s[3 * 36] * scale); o.y = pg8::pk4_fp8(s[4 * 36] * scale, s[5 * 36] * scale, s[6 * 36] * scale, s[7 * 36] * scale);
        o.z = pg8::pk4_fp8(s[8 * 36] * scale, s[9 * 36] * scale, s[10 * 36] * scale, s[11 * 36] * scale); o.w = pg8::pk4_fp8(s[12 * 36] * scale, s[13 * 36] * scale, s[14 * 36] * scale, s[15 * 36] * scale);
        *(u32x4*)(rp(n0 + n) + k0 + 16 * kc) = o; }
    LDS_WAIT(); asm volatile("" ::: "memory");
}
struct RowPlain8 { unsigned char* base; int K; __device__ __forceinline__ unsigned char* operator()(int n) const { return base + (size_t)n * K; } };
struct RowGU8 { unsigned char* base; __device__ __forceinline__ unsigned char* operator()(int n) const { const int f = n >> 1; return base + (size_t)((f >> 7) * 256 + (n & 1) * 128 + (f & 127)) * D; } };
struct RowPlain { bf16_t* base; int K; __device__ __forceinline__ bf16_t* operator()(int n) const { return base + (size_t)n * K; } };
struct RowIn8 { unsigned char* w1; unsigned char* w2;
    __device__ __forceinline__ unsigned char* operator()(int n) const {
        if (n < 1536) return w1 + (size_t)n * D;
        if (n < 2048) { const int j = n - 1536, qk = j >> 8, jj = j & 255, hh = jj >> 6, d = jj & 63, dn = d < 32 ? 2 * d : 2 * (d - 32) + 1; return w2 + (size_t)(qk * 256 + hh * 64 + dn) * D; }
        if (n < 2560) return w1 + (size_t)(1536 + n - 2048) * D;
        return w2 + (size_t)(512 + n - 2560) * D; } };

__device__ __forceinline__ void prologue_phase(const Ctx& c0) { PH_ENTER();
    unsigned char* ws = c.ws;
#ifdef PRO_REP_A
    for (int prep_ = 0, pn_ = [] { int n_ = PRO_REP_A; asm volatile("" : "+s"(n_)); return n_; }(); prep_ < pn_; ++prep_)
#endif
    {
        LAS float* scr = (LAS float*)(c.lds + c.wave * 16384);
        const int gw = c.vcu * 8 + c.wave, NGW = c.G * 8;
        constexpr int N_IN_ = DEPTH * 16 * 160, N_HY = DEPTH * 8 * 32, N_RET = N_HY, N_OUT = DEPTH * 16 * 32, N_GU = DEPTH * NE * 16 * 64, N_DN = DEPTH * NE * 16 * 32;
        constexpr int NITEMS = N_IN_ + N_HY + N_RET + N_OUT + N_GU + N_DN;
#define TITEM_DECODE(it_, kind_, mi_, kb_, nb_, src_, N_) do { int r_ = (it_); \
            if (r_ < N_IN_) { kind_ = 0; mi_ = r_ / 2560; const int q_ = r_ % 2560; kb_ = q_ / 160; nb_ = q_ % 160; N_ = INC; src_ = p->in[I_WIN] + (size_t)mi_ * D * INC; } \
            else if ((r_ -= N_IN_) < N_HY) { kind_ = 1; mi_ = r_ / 256; const int q_ = r_ % 256; kb_ = q_ / 32; nb_ = q_ % 32; N_ = D; src_ = p->in[I_WHY] + (size_t)mi_ * 512 * D; } \
            else if ((r_ -= N_HY) < N_RET) { kind_ = 2; mi_ = r_ / 256; const int q_ = r_ % 256; kb_ = q_ / 32; nb_ = q_ % 32; N_ = D; src_ = p->in[I_WRET] + (size_t)mi_ * 512 * D; } \
            else if ((r_ -= N_RET) < N_OUT) { kind_ = 3; mi_ = r_ / 512; const int q_ = r_ % 512; kb_ = q_ / 32; nb_ = q_ % 32; N_ = D; src_ = p->in[I_WOUT] + (size_t)mi_ * D * D; } \
            else if ((r_ -= N_OUT) < N_GU) { kind_ = 4; mi_ = r_ / 1024; const int q_ = r_ % 1024; kb_ = q_ / 64; nb_ = q_ % 64; N_ = 2048; src_ = p->in[I_WGU] + (size_t)mi_ * D * 2048; } \
            else { r_ -= N_GU; kind_ = 5; mi_ = r_ / 512; const int q_ = r_ % 512; kb_ = q_ / 32; nb_ = q_ % 32; N_ = D; src_ = p->in[I_WDN] + (size_t)mi_ * FF * D; } \
            src_ += (size_t)(kb_ * 64) * N_ + nb_ * 32; } while (0)
        f32x4 cur[8], nxt[8]; int kind = 0, mi = 0, kb = 0, nb = 0, N = 0; const float* src = nullptr;
        if (gw < NITEMS) { TITEM_DECODE(gw, kind, mi, kb, nb, src, N); titem_load(cur, src, N, c.lane); }
        for (int it = gw; it < NITEMS; it += NGW) {
            int kind2 = 0, mi2 = 0, kb2 = 0, nb2 = 0, N2 = 0; const float* src2 = nullptr; const bool more = it + NGW < NITEMS;
            if (more) { TITEM_DECODE(it + NGW, kind2, mi2, kb2, nb2, src2, N2); titem_load(nxt, src2, N2, c.lane); }
            titem_to_lds(cur, scr, c.lane);
            const int k0 = kb * 64, n0 = nb * 32;
            if (kind == 0) { RowIn8 rp{ws + WS_WIN1 + (size_t)mi * P1R * D, ws + WS_WIN2 + (size_t)mi * P2C * D}; titem_store_fp8(scr, c.lane, k0, n0, rp, 32.0f); }
            else if (kind == 1) { RowPlain rp{(bf16_t*)(ws + WS_WHY) + (size_t)mi * D * 512, 512}; titem_store_bf16(scr, c.lane, k0, n0, rp); }
            else if (kind == 2) { RowPlain rp{(bf16_t*)(ws + WS_WRET) + (size_t)mi * D * 512, 512}; titem_store_bf16(scr, c.lane, k0, n0, rp); }
            else if (kind == 3) { RowPlain rp{(bf16_t*)(ws + WS_WOUT) + (size_t)mi * D * D, D}; titem_store_bf16(scr, c.lane, k0, n0, rp); }
            else if (kind == 4) { RowGU8 rp{ws + WS_WGU + (size_t)mi * 2048 * D}; titem_store_fp8(scr, c.lane, k0, n0, rp, 32.0f); }
            else { RowPlain8 rp{ws + WS_WDN + (size_t)mi * D * FF, FF}; titem_store_fp8(scr, c.lane, k0, n0, rp, 32.0f); }
            if (more) {
#pragma unroll
                for (int i = 0; i < 8; ++i) cur[i] = nxt[i];
                kind = kind2; mi = mi2; kb = kb2; nb = nb2; }
        }
#undef TITEM_DECODE
    }
    __syncthreads();
    {
        float* rope = (float*)(ws + WS_ROPE);
        for (int idx = c.vcu * NT + c.tid; idx < S * 32; idx += c.G * NT) { const int pos = idx >> 5, i = idx & 31;
            const float inv = 1.0f / powf(10000.0f, (float)(2 * i) / 64.0f); const float ang = (float)pos * inv;
            rope[2 * idx] = cosf(ang); rope[2 * idx + 1] = sinf(ang); }
    }
#ifdef PRO_REP_C
    for (int prep_ = 0, pn_ = [] { int n_ = PRO_REP_C; asm volatile("" : "+s"(n_)); return n_; }(); prep_ < pn_; ++prep_)
#endif
    {
        LAS float* ca = (LAS float*)c.lds;
        LAS float* red = (LAS float*)(c.lds + 16384);
        for (int i = c.tid; i < NB * D; i += NT) { const float v = p->in[I_C][i]; ca[i] = v / (1.0f + __expf(-v)); }
        __syncthreads();
        float* mod = (float*)(ws + WS_MOD);
        for (int it = c.vcu; it < DEPTH * 96; it += c.G) { const int l = it / 96, nb = it % 96, n = nb * 64 + c.lane;
            const float* w = p->in[I_WMOD] + (size_t)l * D * 6144 + n; float a0 = 0.f, a1 = 0.f, a2 = 0.f, a3 = 0.f;
            const int kb = c.wave * 128;
#pragma unroll 8
            for (int k = 0; k < 128; ++k) { const float wv = w[(size_t)(kb + k) * 6144]; a0 += ca[kb + k] * wv; a1 += ca[1024 + kb + k] * wv; a2 += ca[2048 + kb + k] * wv; a3 += ca[3072 + kb + k] * wv; }
            red[(c.wave * 4 + 0) * 64 + c.lane] = a0; red[(c.wave * 4 + 1) * 64 + c.lane] = a1; red[(c.wave * 4 + 2) * 64 + c.lane] = a2; red[(c.wave * 4 + 3) * 64 + c.lane] = a3;
            __syncthreads();
            if (c.tid < 256) { const int b = c.tid >> 6, ln = c.tid & 63; float s = 0.f;
#pragma unroll
                for (int w8 = 0; w8 < 8; ++w8) s += red[(w8 * 4 + b) * 64 + ln];
                mod[(size_t)(l * NB + b) * 6144 + nb * 64 + ln] = s + p->in[I_BMOD][l * 6144 + nb * 64 + ln]; }
            __syncthreads();
        }
    }
}
__device__ __forceinline__ void expert_tile_prefix(const unsigned* cnt, LAS int* tab, int tid) {
    if (tid < 32) tab[32 + tid] = (int)__hip_atomic_load(cnt + tid, __ATOMIC_RELAXED, __HIP_MEMORY_SCOPE_AGENT);
    __syncthreads();
    if (tid < 32) { int pre = 0;
        for (int q = 0; q < tid; ++q) pre += (tab[32 + q] + 255) >> 8;
        tab[tid] = pre * 256; if (tid == 31) tab[64] = pre + ((tab[63] + 255) >> 8); }
}

template <int MODE>
__device__ __forceinline__ void norm_phase(const Ctx& c0, int l, const int dry = 0) { PH_ENTER();
    unsigned char* ws = c.ws;
    LAS float* wrT = (LAS float*)c.lds;
    LAS int* tab = (LAS int*)(c.lds + LDS_TAB);
    LAS int* lcount = tab + 128;
    LAS int* lbase = tab + 160;
    LAS int* asg_e = tab + 256;
    LAS int* asg_r = tab + 768;
    unsigned* counts = (unsigned*)(ws + WS_CTL) + CW_CNT;
    bf16_t* X = (bf16_t*)(ws + WS_X); bf16_t* H = (bf16_t*)(ws + WS_H);
    const float* mod = (const float*)(ws + WS_MOD);
    int* tok_e = (int*)(ws + WS_TOKE); float* tok_g = (float*)(ws + WS_TOKG); int* tok_p = (int*)(ws + WS_TOKP); int* slot_tok = (int*)(ws + WS_SLOT);
    const bf16_t* YB = (const bf16_t*)(ws + WS_YB);
    const int lp = (MODE == 3) ? DEPTH - 1 : l - 1;
    if (MODE == 1 || MODE == 3) expert_tile_prefix(counts + lp * 32, tab, c.tid);
    if (MODE == 2) { const float* wr = p->in[I_WR] + (size_t)l * D * NE;
        for (int idx = c.tid; idx < D * NE; idx += NT) { const int cc = idx >> 5, e = idx & 31; wrT[e * D + cc] = wr[idx]; } }
    __syncthreads();
    const float* gvec = (MODE == 3) ? p->in[I_FG] : (MODE == 2 ? p->in[I_NFG] + l * D : p->in[I_NMG] + l * D);
    for (int blk = c.vcu; blk < T / 128; blk += c.G) {
        if (MODE == 2) { if (c.tid < 32) lcount[c.tid] = 0; __syncthreads(); }
        for (int r = 0; r < 16; ++r) {
            const int tl = c.wave * 16 + r, t = blk * 128 + tl, b = t >> 13;
            f32x4 v[4];
#pragma unroll
            for (int j = 0; j < 4; ++j) v[j] = (MODE == 0) ? *(const f32x4*)(p->in[I_X] + (size_t)t * D + 4 * c.lane + 256 * j) : bf4_to_f32(*(const u32x2*)(X + (size_t)t * D + 4 * c.lane + 256 * j));
            if (MODE == 1 || MODE == 3) {
                const float* gaf = mod + (size_t)(lp * NB + b) * 6144 + 5 * 1024;
                f32x4 s[4] = {{0.f, 0.f, 0.f, 0.f}, {0.f, 0.f, 0.f, 0.f}, {0.f, 0.f, 0.f, 0.f}, {0.f, 0.f, 0.f, 0.f}};
#pragma unroll
                for (int k = 0; k < 4; ++k) { const int e = tok_e[t * 4 + k], ps = tok_p[t * 4 + k]; const float gk = tok_g[t * 4 + k];
#pragma unroll
                    for (int j = 0; j < 4; ++j) { const int w = *(const int*)((const unsigned char*)YB + (size_t)(tab[e] + ps) * D + 4 * c.lane + 256 * j);
                        s[j] += gk * (f32x4){__builtin_amdgcn_cvt_f32_fp8(w, 0), __builtin_amdgcn_cvt_f32_fp8(w, 1), __builtin_amdgcn_cvt_f32_fp8(w, 2), __builtin_amdgcn_cvt_f32_fp8(w, 3)}; } }
#pragma unroll
                for (int j = 0; j < 4; ++j) { const f32x4 g = *(const f32x4*)(gaf + 4 * c.lane + 256 * j); v[j] += g * s[j]; if (MODE == 1 && !dry) { u32x2 w; w.x = pk2(v[j].x, v[j].y); w.y = pk2(v[j].z, v[j].w); *(u32x2*)(X + (size_t)t * D + 4 * c.lane + 256 * j) = w; } }
            }
            float ss = 0.f;
#pragma unroll
            for (int j = 0; j < 4; ++j) ss += (v[j].x * v[j].x + v[j].y * v[j].y) + (v[j].z * v[j].z + v[j].w * v[j].w);
            const float rstd = 1.0f / sqrtf(wave_sum(ss, c.lane) * (1.0f / D) + EPS);
            if (MODE == 3) {
#pragma unroll
                for (int j = 0; j < 4; ++j) { const f32x4 g = *(const f32x4*)(gvec + 4 * c.lane + 256 * j); *(f32x4*)(p->out + (size_t)t * D + 4 * c.lane + 256 * j) = v[j] * rstd * g; }
                continue;
            }
            const float* mrow = mod + (size_t)(l * NB + b) * 6144 + (MODE == 2 ? 3 * 1024 : 0);
#pragma unroll
            for (int j = 0; j < 4; ++j) { const int cc = 4 * c.lane + 256 * j; const f32x4 g = *(const f32x4*)(gvec + cc), sh = *(const f32x4*)(mrow + cc), sc = *(const f32x4*)(mrow + 1024 + cc);
                v[j] = (v[j] * rstd * g) * (1.0f + sc) + sh;
                { *(unsigned*)(ws + WS_H8A + (size_t)t * D + cc) = pg8::pk4_fp8(v[j].x, v[j].y, v[j].z, v[j].w); } }
            if (MODE == 2) {
                float mylg = -3.0e38f;
#pragma unroll 2
                for (int e = 0; e < 32; ++e) { float s = 0.f;
#pragma unroll
                    for (int j = 0; j < 4; ++j) { const f32x4 w = *(const LAS f32x4*)(wrT + e * D + 4 * c.lane + 256 * j); s += (v[j].x * w.x + v[j].y * w.y) + (v[j].z * w.z + v[j].w * w.w); }
                    const float tot = wave_sum(s, c.lane) + p->in[I_BR][l * NE + e]; mylg = (c.lane == e) ? tot : mylg; }
                int idx[4]; float val[4];
#pragma unroll
                for (int k = 0; k < 4; ++k) { float bv = mylg; int bi = c.lane;
#define TOP_STEP(OV, OI) do { const float ov = (OV); const int oi = (OI); const bool take = (ov > bv) || (ov == bv && oi < bi); bv = take ? ov : bv; bi = take ? oi : bi; } while (0)
                    TOP_STEP(swz_xor<1>(bv), swz_xor_i<1>(bi)); TOP_STEP(swz_xor<2>(bv), swz_xor_i<2>(bi)); TOP_STEP(swz_xor<4>(bv), swz_xor_i<4>(bi)); TOP_STEP(swz_xor<8>(bv), swz_xor_i<8>(bi));
                    TOP_STEP(swz_xor<16>(bv), swz_xor_i<16>(bi)); TOP_STEP(xor32(bv, c.lane), xor32_i(bi, c.lane));
#undef TOP_STEP
                    idx[k] = bi; val[k] = bv; mylg = (c.lane == bi) ? -3.0e38f : mylg; }
                const float e1 = __expf(val[1] - val[0]), e2 = __expf(val[2] - val[0]), e3 = __expf(val[3] - val[0]); const float inv = 1.0f / (1.0f + e1 + e2 + e3);
                if (c.lane < 4) { const int k = c.lane; const int e = k == 0 ? idx[0] : (k == 1 ? idx[1] : (k == 2 ? idx[2] : idx[3])); const float gk = (k == 0 ? 1.0f : (k == 1 ? e1 : (k == 2 ? e2 : e3))) * inv;
                    const int rk = __hip_atomic_fetch_add(lcount + e, 1, __ATOMIC_RELAXED, __HIP_MEMORY_SCOPE_WORKGROUP);
                    asg_e[tl * 4 + k] = e; asg_r[tl * 4 + k] = rk; tok_e[t * 4 + k] = e; tok_g[t * 4 + k] = gk; }
            }
        }
        if (MODE == 2) {
            __syncthreads();
            if (c.tid < 32) lbase[c.tid] = dry ? 0 : (int)__hip_atomic_fetch_add(counts + l * 32 + c.tid, (unsigned)lcount[c.tid], __ATOMIC_RELAXED, __HIP_MEMORY_SCOPE_AGENT);
            __syncthreads();
            { const int a = c.tid, e = asg_e[a], ps = lbase[e] + asg_r[a], t = blk * 128 + (a >> 2); if (!dry) { tok_p[t * 4 + (a & 3)] = ps; slot_tok[e * CAP + ps] = t; } }
            __syncthreads();
        }
    }
}

__device__ __forceinline__ float reduce32(float (&s)[32], int lane) {
    const bool h5 = (lane & 32) != 0, h4 = (lane & 16) != 0, h3 = (lane & 8) != 0, h2 = (lane & 4) != 0, h1 = (lane & 2) != 0;
#pragma unroll
    for (int i = 0; i < 16; ++i) { const float keep = h5 ? s[i + 16] : s[i], send = h5 ? s[i] : s[i + 16]; s[i] = keep + xor32(send, lane); }
#pragma unroll
    for (int i = 0; i < 8; ++i) { const float keep = h4 ? s[i + 8] : s[i], send = h4 ? s[i] : s[i + 8]; s[i] = keep + swz_xor<16>(send); }
#pragma unroll
    for (int i = 0; i < 4; ++i) { const float keep = h3 ? s[i + 4] : s[i], send = h3 ? s[i] : s[i + 4]; s[i] = keep + swz_xor<8>(send); }
#pragma unroll
    for (int i = 0; i < 2; ++i) { const float keep = h2 ? s[i + 2] : s[i], send = h2 ? s[i] : s[i + 2]; s[i] = keep + swz_xor<4>(send); }
    { const float keep = h1 ? s[1] : s[0], send = h1 ? s[0] : s[1]; s[0] = keep + swz_xor<2>(send); }
    return s[0] + swz_xor<1>(s[0]);
}
__device__ __forceinline__ void top4_lanes(float mylg, const int elane, const int lane, int (&idx)[4], float (&val)[4]) {
#pragma unroll
    for (int k = 0; k < 4; ++k) { float bv = mylg; int bi = elane;
#define TOP_STEP(OV, OI) do { const float ov = (OV); const int oi = (OI); const bool take = (ov > bv) || (ov == bv && oi < bi); bv = take ? ov : bv; bi = take ? oi : bi; } while (0)
        TOP_STEP(swz_xor<2>(bv), swz_xor_i<2>(bi)); TOP_STEP(swz_xor<4>(bv), swz_xor_i<4>(bi)); TOP_STEP(swz_xor<8>(bv), swz_xor_i<8>(bi)); TOP_STEP(swz_xor<16>(bv), swz_xor_i<16>(bi)); TOP_STEP(xor32(bv, lane), xor32_i(bi, lane));
#undef TOP_STEP
        idx[k] = bi; val[k] = bv; mylg = (elane == bi) ? -3.0e38f : mylg; }
}
constexpr int NF_XS = 2064;
__device__ __forceinline__ void normf_phase(const Ctx& c0, int l, const int dry = 0) { PH_ENTER();
    unsigned char* ws = c.ws;
    LAS unsigned char* XH = c.lds; LAS unsigned char* XL = c.lds + 16 * NF_XS; LAS float* PART = (LAS float*)(c.lds + 32 * NF_XS);
    LAS int* tab = (LAS int*)(c.lds + 32 * NF_XS + 16384); LAS int* lcount = tab; LAS int* lbase = tab + 32; LAS int* asg_e = tab + 64; LAS int* asg_r = tab + 576;
    unsigned* counts = (unsigned*)(ws + WS_CTL) + CW_CNT;
    const bf16_t* X = (const bf16_t*)(ws + WS_X); unsigned char* H8 = ws + WS_H; const float* mod = (const float*)(ws + WS_MOD);
    int* tok_e = (int*)(ws + WS_TOKE); float* tok_g = (float*)(ws + WS_TOKG); int* tok_p = (int*)(ws + WS_TOKP); int* slot_tok = (int*)(ws + WS_SLOT);
    const int fr = c.lane & 15, fq = c.lane >> 4;
    bf16x8 yh[2][4], yl[2][4];
    { const float* wr = p->in[I_WR] + (size_t)l * D * NE;
#pragma unroll
      for (int ct = 0; ct < 2; ++ct)
#pragma unroll
        for (int ks = 0; ks < 4; ++ks) { unsigned hw[4], lw[4];
#pragma unroll
            for (int i2 = 0; i2 < 4; ++i2) { const float a = wr[(size_t)(128 * c.wave + 32 * ks + 8 * fq + 2 * i2) * NE + 16 * ct + fr], b_ = wr[(size_t)(128 * c.wave + 32 * ks + 8 * fq + 2 * i2 + 1) * NE + 16 * ct + fr];
                hw[i2] = pk2(a, b_); lw[i2] = pk2(a - bf_lo(hw[i2]), b_ - bf_hi(hw[i2])); }
            yh[ct][ks] = __builtin_bit_cast(bf16x8, (u32x4){hw[0], hw[1], hw[2], hw[3]}); yl[ct][ks] = __builtin_bit_cast(bf16x8, (u32x4){lw[0], lw[1], lw[2], lw[3]}); } }
    const float* gvec = p->in[I_NFG] + l * D; const float brl = p->in[I_BR][l * NE + (c.lane & 31)];
    for (int blk = c.vcu; blk < T / 128; blk += c.G) {
        __syncthreads();
        if (c.tid < 32) lcount[c.tid] = 0;
        const int b = (blk * 128) >> 13; const float* mrow = mod + (size_t)(l * NB + b) * 6144 + 3 * 1024;
        u32x2 n0[4], n1[4];
        { const int t = blk * 128 + 2 * c.wave;
#pragma unroll
          for (int j = 0; j < 4; ++j) { n0[j] = *(const u32x2*)(X + (size_t)t * D + 4 * c.lane + 256 * j); n1[j] = *(const u32x2*)(X + (size_t)(t + 1) * D + 4 * c.lane + 256 * j); } }
        for (int tile = 0; tile < 8; ++tile) {
            const int t = blk * 128 + tile * 16 + 2 * c.wave;
            f32x4 v0[4], v1[4];
#pragma unroll
            for (int j = 0; j < 4; ++j) { v0[j] = bf4_to_f32(n0[j]); v1[j] = bf4_to_f32(n1[j]); }
            if (tile < 7) {
#pragma unroll
                for (int j = 0; j < 4; ++j) { n0[j] = *(const u32x2*)(X + (size_t)(t + 16) * D + 4 * c.lane + 256 * j); n1[j] = *(const u32x2*)(X + (size_t)(t + 17) * D + 4 * c.lane + 256 * j); } }
            float ss0 = 0.f, ss1 = 0.f;
#pragma unroll
            for (int j = 0; j < 4; ++j) { ss0 += (v0[j].x * v0[j].x + v0[j].y * v0[j].y) + (v0[j].z * v0[j].z + v0[j].w * v0[j].w); ss1 += (v1[j].x * v1[j].x + v1[j].y * v1[j].y) + (v1[j].z * v1[j].z + v1[j].w * v1[j].w); }
            const float rs0 = 1.0f / sqrtf(wave_sum(ss0, c.lane) * (1.0f / D) + EPS), rs1 = 1.0f / sqrtf(wave_sum(ss1, c.lane) * (1.0f / D) + EPS);
#pragma unroll
            for (int j = 0; j < 4; ++j) { const int cc = 4 * c.lane + 256 * j; const f32x4 g = *(const f32x4*)(gvec + cc), sh = *(const f32x4*)(mrow + cc), sc = *(const f32x4*)(mrow + 1024 + cc);
                v0[j] = (v0[j] * rs0 * g) * (1.0f + sc) + sh; v1[j] = (v1[j] * rs1 * g) * (1.0f + sc) + sh;
                *(unsigned*)(H8 + (size_t)t * D + cc) = pg8::pk4_fp8(v0[j].x, v0[j].y, v0[j].z, v0[j].w); *(unsigned*)(H8 + (size_t)(t + 1) * D + cc) = pg8::pk4_fp8(v1[j].x, v1[j].y, v1[j].z, v1[j].w);
                u32x2 h0, l0, h1, l1;
                h0.x = pk2(v0[j].x, v0[j].y); h0.y = pk2(v0[j].z, v0[j].w); l0.x = pk2(v0[j].x - bf_lo(h0.x), v0[j].y - bf_hi(h0.x)); l0.y = pk2(v0[j].z - bf_lo(h0.y), v0[j].w - bf_hi(h0.y));
                h1.x = pk2(v1[j].x, v1[j].y); h1.y = pk2(v1[j].z, v1[j].w); l1.x = pk2(v1[j].x - bf_lo(h1.x), v1[j].y - bf_hi(h1.x)); l1.y = pk2(v1[j].z - bf_lo(h1.y), v1[j].w - bf_hi(h1.y));
                *(LAS u32x2*)(XH + (2 * c.wave) * NF_XS + cc * 2) = h0; *(LAS u32x2*)(XL + (2 * c.wave) * NF_XS + cc * 2) = l0;
                *(LAS u32x2*)(XH + (2 * c.wave + 1) * NF_XS + cc * 2) = h1; *(LAS u32x2*)(XL + (2 * c.wave + 1) * NF_XS + cc * 2) = l1; }
            __syncthreads();
            { f32x4 a0 = {0.f, 0.f, 0.f, 0.f}, a1 = {0.f, 0.f, 0.f, 0.f};
#pragma unroll
              for (int ks = 0; ks < 4; ++ks) { const int kel = 128 * c.wave + 32 * ks + 8 * fq;
                  const bf16x8 xh = *(const LAS bf16x8*)(XH + fr * NF_XS + kel * 2), xl = *(const LAS bf16x8*)(XL + fr * NF_XS + kel * 2);
                  a0 = __builtin_amdgcn_mfma_f32_16x16x32_bf16(xh, yh[0][ks], a0, 0, 0, 0); a0 = __builtin_amdgcn_mfma_f32_16x16x32_bf16(xl, yh[0][ks], a0, 0, 0, 0); a0 = __builtin_amdgcn_mfma_f32_16x16x32_bf16(xh, yl[0][ks], a0, 0, 0, 0);
                  a1 = __builtin_amdgcn_mfma_f32_16x16x32_bf16(xh, yh[1][ks], a1, 0, 0, 0); a1 = __builtin_amdgcn_mfma_f32_16x16x32_bf16(xl, yh[1][ks], a1, 0, 0, 0); a1 = __builtin_amdgcn_mfma_f32_16x16x32_bf16(xh, yl[1][ks], a1, 0, 0, 0); }
#pragma unroll
              for (int r = 0; r < 4; ++r) { PART[(c.wave * 16 + 4 * fq + r) * 32 + fr] = a0[r]; PART[(c.wave * 16 + 4 * fq + r) * 32 + 16 + fr] = a1[r]; } }
            __syncthreads();
            { const int tok = 2 * c.wave + (c.lane >> 5), e = c.lane & 31; float lg = brl;
#pragma unroll
              for (int w8 = 0; w8 < 8; ++w8) lg += PART[(w8 * 16 + tok) * 32 + e];
              int idx[4]; float val[4]; float mylg = lg;
#pragma unroll
              for (int k = 0; k < 4; ++k) { float bv = mylg; int bi = e;
#define TOP_STEP(OV, OI) do { const float ov = (OV); const int oi = (OI); const bool take = (ov > bv) || (ov == bv && oi < bi); bv = take ? ov : bv; bi = take ? oi : bi; } while (0)
                  TOP_STEP(dpp_f<DPP_X1>(bv), dpp_i<DPP_X1>(bi)); TOP_STEP(dpp_f<DPP_X2>(bv), dpp_i<DPP_X2>(bi)); TOP_STEP(dpp_f<DPP_HM>(bv), dpp_i<DPP_HM>(bi)); TOP_STEP(dpp_f<DPP_RM>(bv), dpp_i<DPP_RM>(bi)); TOP_STEP(swz_xor<16>(bv), swz_xor_i<16>(bi));
#undef TOP_STEP
                  idx[k] = bi; val[k] = bv; mylg = (e == bi) ? -3.0e38f : mylg; }
              if (e < 4) { const int k = e; const int ek = k == 0 ? idx[0] : (k == 1 ? idx[1] : (k == 2 ? idx[2] : idx[3])); const float vk = k == 0 ? val[0] : (k == 1 ? val[1] : (k == 2 ? val[2] : val[3]));
                  const float gk = __expf(vk - val[0]) / (1.0f + __expf(val[1] - val[0]) + __expf(val[2] - val[0]) + __expf(val[3] - val[0]));
                  const int tl = tile * 16 + tok, tt = blk * 128 + tl;
                  const int rk = __hip_atomic_fetch_add(lcount + ek, 1, __ATOMIC_RELAXED, __HIP_MEMORY_SCOPE_WORKGROUP);
                  asg_e[tl * 4 + k] = ek; asg_r[tl * 4 + k] = rk; tok_e[tt * 4 + k] = ek; tok_g[tt * 4 + k] = gk; } }
        }
        __syncthreads();
        if (c.tid < 32) lbase[c.tid] = dry ? 0 : (int)__hip_atomic_fetch_add(counts + l * 32 + c.tid, (unsigned)lcount[c.tid], __ATOMIC_RELAXED, __HIP_MEMORY_SCOPE_AGENT);
        __syncthreads();
        { const int a = c.tid, e = asg_e[a], ps = lbase[e] + asg_r[a], t = blk * 128 + (a >> 2); if (!dry) { tok_p[t * 4 + (a & 3)] = ps; slot_tok[e * CAP + ps] = t; } }
    }
}

__device__ __forceinline__ void transpose_yhy_phase(const Ctx& c0) { PH_ENTER(); (void)p;
    const bf16_t* src = (const bf16_t*)(c.ws + WS_YHYT); bf16_t* dst = (bf16_t*)(c.ws + WS_YHY);
    LAS bf16_t* tile = (LAS bf16_t*)(c.lds + c.wave * 16384);
    const int gw = c.vcu * 8 + c.wave, NGW = c.G * 8, r8 = c.lane >> 3, q8 = c.lane & 7;
    u32x4 v[8];
    if (gw < 8 * (T / 64)) {
#pragma unroll
        for (int i = 0; i < 8; ++i) v[i] = *(const u32x4*)(src + (size_t)((gw & 7) * 64 + i * 8 + r8) * T + (gw >> 3) * 64 + q8 * 8);
    }
    for (int it = gw; it < 8 * (T / 64); it += NGW) { const int cb = it & 7, tb = it >> 3, ch0 = cb * 64, t0 = tb * 64;
#pragma unroll
        for (int i = 0; i < 8; ++i) { LAS unsigned* wp = (LAS unsigned*)(tile + (i * 8 + r8) * 66 + q8 * 8); wp[0] = v[i].x; wp[1] = v[i].y; wp[2] = v[i].z; wp[3] = v[i].w; }
        const int nx = it + NGW;
        if (nx < 8 * (T / 64)) {
#pragma unroll
            for (int i = 0; i < 8; ++i) v[i] = *(const u32x4*)(src + (size_t)((nx & 7) * 64 + i * 8 + r8) * T + (nx >> 3) * 64 + q8 * 8);
        }
        LDS_WAIT(); asm volatile("" ::: "memory");
#pragma unroll
        for (int i = 0; i < 8; ++i) { const int tt = i * 8 + r8; unsigned w[4];
#pragma unroll
            for (int k = 0; k < 4; ++k) w[k] = (unsigned)tile[(q8 * 8 + 2 * k) * 66 + tt] | ((unsigned)tile[(q8 * 8 + 2 * k + 1) * 66 + tt] << 16);
            *(u32x4*)(dst + (size_t)(t0 + tt) * 512 + ch0 + q8 * 8) = (u32x4){w[0], w[1], w[2], w[3]}; }
        LDS_WAIT(); asm volatile("" ::: "memory");
    }
}
__device__ __forceinline__ float block_sum512(float v, LAS float* red, int tid) {
    v = wave_sum(v, tid & 63); __syncthreads(); if ((tid & 63) == 0) red[tid >> 6] = v; __syncthreads();
    float s = 0.f;
#pragma unroll
    for (int i = 0; i < 8; ++i) s += red[i];
    return s;
}
__device__ __forceinline__ float shortconv_at(const bf16_t* row, int t, float w0, float w1, float w2, float bb) {
    const float xm = t > 0 ? bf2f(row[t - 1]) : 0.f, x0 = bf2f(row[t]), xp = t < S - 1 ? bf2f(row[t + 1]) : 0.f;
    return xm * w0 + x0 * w1 + xp * w2 + bb;
}
#ifndef FD
#define FD __device__ __forceinline__
#endif
#ifndef LASQ
#define LASQ LAS
#endif
#if defined(__HIP__)
#define FFT_SCHED() __builtin_amdgcn_sched_barrier(0)
typedef float cf __attribute__((ext_vector_type(2)));
FD cf fld_(const LASQ cf* b, int i) { return b[i]; }
FD void fst_(LASQ cf* b, int i, cf v) { b[i] = v; }
FD cf cadd(cf a, cf b) { return a + b; }
FD cf csub(cf a, cf b) { return a - b; }
FD cf cmul(cf a, cf b) { cf t, r;
    asm("v_pk_mul_f32 %0, %1, %2 op_sel_hi:[0,1]" : "=v"(t) : "v"(a), "v"(b));
    asm("v_pk_fma_f32 %0, %1, %2, %3 op_sel:[1,1,0] op_sel_hi:[1,0,1] neg_lo:[0,1,0]" : "=v"(r) : "v"(a), "v"(b), "v"(t));
    return r; }
FD cf cmulc(cf a, cf b) { cf t, r;
    asm("v_pk_mul_f32 %0, %1, %2 op_sel_hi:[1,0]" : "=v"(t) : "v"(a), "v"(b));
    asm("v_pk_fma_f32 %0, %1, %2, %3 op_sel:[1,1,0] op_sel_hi:[0,1,1] neg_hi:[1,0,0]" : "=v"(r) : "v"(a), "v"(b), "v"(t));
    return r; }
#else
#define FFT_SCHED()
struct cf { float x, y; };
FD cf fld_(const LASQ cf* b, int i) { return b[i]; }
FD void fst_(LASQ cf* b, int i, cf v) { b[i] = v; }
FD cf cadd(cf a, cf b) { return cf{a.x + b.x, a.y + b.y}; }
FD cf csub(cf a, cf b) { return cf{a.x - b.x, a.y - b.y}; }
FD cf cmul(cf a, cf b) { return cf{a.x * b.x - a.y * b.y, a.x * b.y + a.y * b.x}; }
FD cf cmulc(cf a, cf b) { return cf{a.x * b.x + a.y * b.y, a.y * b.x - a.x * b.y}; }
#endif
struct FftK { float c1, c2, c3, h, c5, c6, c7; };
FD FftK fft_consts() {
    FftK k{0.98078528040323043f, 0.92387953251128674f, 0.83146961230254524f, 0.70710678118654752f, 0.55557023301960218f, 0.38268343236508977f, 0.19509032201612825f};
#if defined(__HIP__)
    asm volatile("" : "+s"(k.c1), "+s"(k.c2), "+s"(k.c3), "+s"(k.h), "+s"(k.c5), "+s"(k.c6), "+s"(k.c7));
#endif
    return k;
}
FD cf mulw32(cf v, int k, bool inv, const FftK& K) {
    const float h = K.h;
    if (k == 0) return v;
#if defined(__HIP__)
    const float sg = inv ? -1.0f : 1.0f;
    if (k == 8) return v.yx * cf{sg, -sg};
    if (k == 4) return v * h + v.yx * cf{sg * h, -sg * h};
    if (k == 12) return v * -h + v.yx * cf{sg * h, -sg * h};
#else
    const cf rv = inv ? cf{-v.y, v.x} : cf{v.y, -v.x};
    if (k == 8) return rv;
    if (k == 4) return cf{(v.x + rv.x) * h, (v.y + rv.y) * h};
    if (k == 12) return cf{(rv.x - v.x) * h, (rv.y - v.y) * h};
#endif
    const float co = k == 1 ? K.c1 : k == 2 ? K.c2 : k == 3 ? K.c3 : k == 5 ? K.c5 : k == 6 ? K.c6 : k == 7 ? K.c7 : k == 9 ? -K.c7 : k == 10 ? -K.c6 : k == 11 ? -K.c5 : k == 13 ? -K.c3 : k == 14 ? -K.c2 : -K.c1;
    const float si = k == 1 ? K.c7 : k == 2 ? K.c6 : k == 3 ? K.c5 : k == 5 ? K.c3 : k == 6 ? K.c2 : k == 7 ? K.c1 : k == 9 ? K.c1 : k == 10 ? K.c2 : k == 11 ? K.c3 : k == 13 ? K.c5 : k == 14 ? K.c6 : K.c7;
#if defined(__HIP__)
    return v * co + v.yx * cf{sg * si, -sg * si};
#else
    return cf{v.x * co + rv.x * si, v.y * co + rv.y * si};
#endif
}
#if defined(__HIP__)
FD cf add_mi(cf u, cf x) { cf r; asm("v_pk_add_f32 %0, %1, %2 op_sel:[0,1] op_sel_hi:[1,0] neg_hi:[0,1]" : "=v"(r) : "v"(u), "v"(x)); return r; }
FD cf add_pi(cf u, cf x) { cf r; asm("v_pk_add_f32 %0, %1, %2 op_sel:[0,1] op_sel_hi:[1,0] neg_lo:[0,1]" : "=v"(r) : "v"(u), "v"(x)); return r; }
#else
FD cf add_mi(cf u, cf x) { return cf{u.x + x.y, u.y - x.x}; }
FD cf add_pi(cf u, cf x) { return cf{u.x - x.y, u.y + x.x}; }
#endif
template <int N, bool PEND = false> FD void dif(cf* a, const FftK& K) {
#pragma unroll
    for (int k = 0; k < N / 2; ++k) { cf u, v;
        if (PEND && k == 0) { u = add_mi(a[0], a[N / 2]); v = add_pi(a[0], a[N / 2]); } else { u = cadd(a[k], a[k + N / 2]); v = csub(a[k], a[k + N / 2]); }
        a[k] = u; a[k + N / 2] = (N >= 4 && k == N / 4) ? v : mulw32(v, k * (32 / N), false, K); }
    if constexpr (N > 2) { dif<N / 2, false>(a, K); dif<N / 2, (N >= 4)>(a + N / 2, K); }
}
template <int N> FD void idif(cf* a, const FftK& K) {
    if constexpr (N > 2) { idif<N / 2>(a, K); idif<N / 2>(a + N / 2, K); }
#pragma unroll
    for (int k = 0; k < N / 2; ++k) {
        if (N >= 4 && k == N / 4) { const cf u = a[k], x = a[k + N / 2]; a[k] = add_pi(u, x); a[k + N / 2] = add_mi(u, x); }
        else { const cf t = mulw32(a[k + N / 2], k * (32 / N), true, K), u = a[k]; a[k] = cadd(u, t); a[k + N / 2] = csub(u, t); } }
}
FD constexpr int brev4(int r) { return ((r & 1) << 3) | ((r & 2) << 1) | ((r & 4) >> 1) | ((r & 8) >> 3); }
FD int fphys(int e) { return e + (e >> 5); }
constexpr int FFT_BUF = 8192 + 256;
FD void powers16(cf w, cf* pw) {
    pw[0] = cf{1.0f, 0.0f}; pw[1] = w; pw[2] = cmul(w, w); pw[3] = cmul(pw[2], w); pw[4] = cmul(pw[2], pw[2]); pw[5] = cmul(pw[4], w); pw[6] = cmul(pw[4], pw[2]); pw[7] = cmul(pw[4], pw[3]);
    pw[8] = cmul(pw[4], pw[4]); pw[9] = cmul(pw[8], w); pw[10] = cmul(pw[8], pw[2]); pw[11] = cmul(pw[8], pw[3]); pw[12] = cmul(pw[8], pw[4]); pw[13] = cmul(pw[8], pw[5]); pw[14] = cmul(pw[8], pw[6]); pw[15] = cmul(pw[8], pw[7]);
}
template <int PS> FD void f16_store(cf* a, const cf* pw, LASQ cf* buf, int pb, const FftK& K) {
    dif<16>(a, K);
#pragma unroll
    for (int r = 0; r < 16; ++r) { const cf v = (r == 0) ? a[0] : cmul(a[r], pw[brev4(r)]); fst_(buf + pb, PS * r, v); }
}
template <int PS> FD void i16_load(cf* a, const cf* pw, const LASQ cf* buf, int pb, const FftK& K) {
#pragma unroll
    for (int r = 0; r < 16; ++r) { const cf v = fld_(buf + pb, PS * r); a[r] = (r == 0) ? v : cmulc(v, pw[brev4(r)]); }
    idif<16>(a, K);
}
FD void fft_pass_f2(LASQ cf* bufE, LASQ cf* bufO, const LASQ cf* w512, int t) {
    const FftK K = fft_consts();
    const int i2 = t & 31, pb = (t >> 5) * 528 + i2; cf pw[16]; powers16(fld_(w512, i2), pw); cf a[16];
#pragma unroll
    for (int j = 0; j < 16; ++j) a[j] = fld_(bufE + pb, 33 * j);
    f16_store<33>(a, pw, bufE, pb, K);
#pragma unroll
    for (int j = 0; j < 16; ++j) a[j] = fld_(bufO + pb, 33 * j);
    f16_store<33>(a, pw, bufO, pb, K);
}
FD void fft_pass_i2(LASQ cf* bufE, LASQ cf* bufO, const LASQ cf* w512, int t) {
    const FftK K = fft_consts();
    const int i2 = t & 31, pb = (t >> 5) * 528 + i2; cf pw[16]; powers16(fld_(w512, i2), pw); cf a[16];
    i16_load<33>(a, pw, bufE, pb, K);
#pragma unroll
    for (int j = 0; j < 16; ++j) fst_(bufE + pb, 33 * j, a[j]);
    i16_load<33>(a, pw, bufO, pb, K);
#pragma unroll
    for (int j = 0; j < 16; ++j) fst_(bufO + pb, 33 * j, a[j]);
}
FD int f3_pipe(int t) { return (t >> 5) & 1; }
FD int f3_blk(int t) { return ((t >> 6) << 5) + (t & 31); }
FD void fft_f3_load(cf* a, const LASQ cf* bufE, const LASQ cf* bufO, int t) {
    const LASQ cf* b = f3_pipe(t) ? bufO : bufE; const int base = f3_blk(t) * 33;
#pragma unroll
    for (int r = 0; r < 32; ++r) a[r] = fld_(b, base + r);
    dif<32>(a, fft_consts());
}
FD void fft_i3_store(cf* a, LASQ cf* bufE, LASQ cf* bufO, int t) {
    idif<32>(a, fft_consts());
    LASQ cf* b = f3_pipe(t) ? bufO : bufE; const int base = f3_blk(t) * 33;
#pragma unroll
    for (int r = 0; r < 32; ++r) fst_(b, base + r, a[r]);
}
constexpr int FL_BUFE = 0, FL_BUFO = FFT_BUF * 8, FL_W16 = 2 * FFT_BUF * 8, FL_W8 = FL_W16 + 4096, FL_W512 = FL_W8 + 4096, FL_RED = FL_W512 + 256;
static_assert(FL_RED + 64 <= LDS_BYTES - 16, "fft LDS map");
__device__ __forceinline__ void fft_tables(const Ctx& c) {
    LAS cf* W16 = (LAS cf*)(c.lds + FL_W16); LAS cf* W8 = (LAS cf*)(c.lds + FL_W8); LAS cf* w512 = (LAS cf*)(c.lds + FL_W512);
    { float s, co; sincospif((float)c.tid * (1.0f / 8192.0f), &s, &co); fst_(W16, c.tid, cf{co, -s}); sincospif((float)c.tid * (1.0f / 4096.0f), &s, &co); fst_(W8, c.tid, cf{co, -s});
      if (c.tid < 32) { sincospif((float)c.tid * (1.0f / 256.0f), &s, &co); fst_(w512, c.tid, cf{co, -s}); } }
    __syncthreads();
}
__device__ __forceinline__ int fresh(int t) { asm volatile("" : "+v"(t)); return t; }
__device__ __forceinline__ void fft_forward12(const cf* zE, const cf* zO, const Ctx& c, int tid_) {
    LAS cf* bufE = (LAS cf*)(c.lds + FL_BUFE); LAS cf* bufO = (LAS cf*)(c.lds + FL_BUFO); const LAS cf* W8 = (const LAS cf*)(c.lds + FL_W8); const LAS cf* w512 = (const LAS cf*)(c.lds + FL_W512);
    { const FftK K = fft_consts(); const int t1 = fresh(tid_); cf pw[16]; powers16(fld_(W8, t1), pw); cf a[16];
#pragma unroll
      for (int j = 0; j < 16; ++j) a[j] = zE[j];
      f16_store<528>(a, pw, bufE, t1 + (t1 >> 5), K);
#pragma unroll
      for (int j = 0; j < 16; ++j) a[j] = zO[j];
      f16_store<528>(a, pw, bufO, t1 + (t1 >> 5), K); }
    __syncthreads();
    fft_pass_f2(bufE, bufO, w512, fresh(tid_));
    LDS_WAIT(); asm volatile("" ::: "memory");
}
typedef _Float16 h16x4 __attribute__((ext_vector_type(4)));
struct Sc3Raw { unsigned short own[2][16], nb[2][16]; };
__device__ __forceinline__ void sc3_load_row(const bf16_t* row, int tq, unsigned short (&own)[16], unsigned short (&nb)[16]) {
    const int d = ((tq & 63) == 0) ? -1 : 1; const bf16_t* p = row + tq; const bf16_t* q = p + d;
#pragma unroll
    for (int j = 0; j < 16; ++j) own[j] = p[512 * j];
#pragma unroll
    for (int j = 0; j < 16; ++j) nb[j] = (j == 0) ? row[max(tq + d, 0)] : (j == 15) ? row[min(tq + 7680 + d, S - 1)] : q[512 * j];
}
__device__ __forceinline__ float sc3_eval(unsigned short own, unsigned short nb, int j, int n, float w0, float w1, float w2, float bb) {
    const float x0 = bf2f(own), xh = bf2f(nb);
    const float oldm = (j > 0 || n > 0) ? xh : 0.f, oldp = (j < 15 || n < S - 1) ? xh : 0.f;
    const float xm = __int_as_float(__builtin_amdgcn_update_dpp(__float_as_int(oldm), __float_as_int(x0), 0x138, 0xF, 0xF, false));
    const float xp = __int_as_float(__builtin_amdgcn_update_dpp(__float_as_int(oldp), __float_as_int(x0), 0x130, 0xF, 0xF, false));
    return xm * w0 + x0 * w1 + xp * w2 + bb;
}
__device__ __forceinline__ cf sc3_eval2(unsigned short own_a, unsigned short nb_a, unsigned short own_b, unsigned short nb_b, int j, int n, float w0, float w1, float w2, float bb) {
    const cf x0 = cf{bf2f(own_a), bf2f(own_b)}, xh = cf{bf2f(nb_a), bf2f(nb_b)};
    const bool keepm = (j > 0 || n > 0), keepp = (j < 15 || n < S - 1);
    const cf om = keepm ? xh : cf{0.f, 0.f}, op = keepp ? xh : cf{0.f, 0.f};
    const cf xm = cf{__int_as_float(__builtin_amdgcn_update_dpp(__float_as_int(om.x), __float_as_int(x0.x), 0x138, 0xF, 0xF, false)), __int_as_float(__builtin_amdgcn_update_dpp(__float_as_int(om.y), __float_as_int(x0.y), 0x138, 0xF, 0xF, false))};
    const cf xp = cf{__int_as_float(__builtin_amdgcn_update_dpp(__float_as_int(op.x), __float_as_int(x0.x), 0x130, 0xF, 0xF, false)), __int_as_float(__builtin_amdgcn_update_dpp(__float_as_int(op.y), __float_as_int(x0.y), 0x130, 0xF, 0xF, false))};
    return xm * w0 + x0 * w1 + xp * w2 + bb;
}
template <bool PRE = false>
__device__ __forceinline__ void fft_conv(cf* z, const h16x4* Kb, const Ctx& c, Sc3Raw* pre = nullptr, const bf16_t* ra = nullptr, const bf16_t* rb = nullptr) {
    LAS cf* bufE = (LAS cf*)(c.lds + FL_BUFE); LAS cf* bufO = (LAS cf*)(c.lds + FL_BUFO); const LAS cf* W16 = (const LAS cf*)(c.lds + FL_W16); const LAS cf* W8 = (const LAS cf*)(c.lds + FL_W8); const LAS cf* w512 = (const LAS cf*)(c.lds + FL_W512);
    { const FftK K = fft_consts(); cf zO[16]; const cf w16 = fld_(W16, fresh(c.tid));
#pragma unroll
      for (int j = 0; j < 16; ++j) zO[j] = cmul(z[j], mulw32(w16, j, false, K));
      fft_forward12(z, zO, c, c.tid); }
    { const int t3 = fresh(c.tid); cf a[32]; h16x4 kk[16];
#pragma unroll
      for (int g = 0; g < 16; ++g) kk[g] = Kb[g * 512 + t3];
      fft_f3_load(a, bufE, bufO, t3);
#pragma unroll
      for (int g = 0; g < 16; ++g) { a[2 * g] = cmul(a[2 * g], cf{(float)kk[g][0], (float)kk[g][1]}); a[2 * g + 1] = cmul(a[2 * g + 1], cf{(float)kk[g][2], (float)kk[g][3]}); }
      fft_i3_store(a, bufE, bufO, t3); }
    LDS_WAIT(); asm volatile("" ::: "memory");
    fft_pass_i2(bufE, bufO, w512, fresh(c.tid));
    __syncthreads();
    if constexpr (PRE) { const int tq = fresh(c.tid);
        sc3_load_row(ra, tq, pre->own[0], pre->nb[0]); sc3_load_row(rb, tq, pre->own[1], pre->nb[1]); }
    { const FftK K = fft_consts(); const int t5 = fresh(c.tid); cf pw[16]; powers16(fld_(W8, t5), pw); cf aO[16]; const cf w16 = fld_(W16, t5);
      i16_load<528>(z, pw, bufE, t5 + (t5 >> 5), K); i16_load<528>(aO, pw, bufO, t5 + (t5 >> 5), K);
#pragma unroll
      for (int j = 0; j < 16; ++j) { const cf s_ = cadd(z[j], cmulc(aO[j], mulw32(w16, j, false, K))); z[j] = cf{s_.x * (1.0f / 16384.0f), s_.y * (1.0f / 16384.0f)}; } }
}
__device__ __forceinline__ void kspec_phase(const Ctx& c0) { PH_ENTER();
    fft_tables(c);
    LAS cf* bufE = (LAS cf*)(c.lds + FL_BUFE); LAS cf* bufO = (LAS cf*)(c.lds + FL_BUFO); const LAS cf* W16 = (const LAS cf*)(c.lds + FL_W16); LAS float* red = (LAS float*)(c.lds + FL_RED);
    const _Float16* kt = (const _Float16*)(c.ws + WS_KT); const float* l1p = (const float*)(c.ws + WS_L1P); h16x4* KF = (h16x4*)(c.ws + WS_KF);
    for (int pr = c.vcu; pr < DEPTH * 2 * 256; pr += c.G) { const int it = 2 * pr, l = it >> 10, o = (it >> 9) & 1, ch = it & 511;
        float pa = 0.f, pb = 0.f;
        if (c.tid < 64) { const float* lp = l1p + ((size_t)l * 64 + c.tid) * 2048 + o * 512 + ch; pa = lp[0] + lp[1024]; pb = lp[1] + lp[1025]; }
        const float sa = 1.0f / block_sum512(pa, red, c.tid); __syncthreads(); const float sb = 1.0f / block_sum512(pb, red, fresh(c.tid));
        const _Float16* kra = kt + (size_t)it * 16384; const _Float16* krb = kra + 16384;
        const float hba = p->in[I_HBIAS][l * 1024 + o * 512 + ch], hbb = p->in[I_HBIAS][l * 1024 + o * 512 + ch + 1];
        { const FftK K = fft_consts(); cf zE[16], zO[16]; const int t1 = fresh(c.tid); const cf w16 = fld_(W16, t1);
#pragma unroll
          for (int j = 0; j < 16; ++j) { const int n = t1 + 512 * j; const float a0 = (float)kra[n] * sa, a1 = (float)kra[n + 8192] * sa, b0 = (float)krb[n] * sb, b1 = (float)krb[n + 8192] * sb;
              zE[j] = cf{a0 + a1, b0 + b1}; zO[j] = cmul(cf{a0 - a1, b0 - b1}, mulw32(w16, j, false, K)); }
          fft_forward12(zE, zO, c, c.tid); }
        { const int t3 = fresh(c.tid); cf a[32]; fft_f3_load(a, bufE, bufO, t3);
          LAS cf* b = f3_pipe(t3) ? bufO : bufE; const int blk = f3_blk(t3), base = blk * 33;
#pragma unroll
          for (int r = 0; r < 32; ++r) fst_(b, base + r, a[r]);
          __syncthreads();
          h16x4* Ka = KF + (size_t)it * 8192; h16x4* Kb = Ka + 8192;
#pragma unroll
          for (int g = 0; g < 16; ++g) { float ka[4], kb[4];
#pragma unroll
              for (int u = 0; u < 2; ++u) { const int r = 2 * g + u; const unsigned pos = (unsigned)(blk * 32 + r);
                  const unsigned mp = f3_pipe(t3) ? 8191u - pos : (__builtin_bitreverse32((8192u - (__builtin_bitreverse32(pos) >> 19)) & 8191u) >> 19);
                  const cf m = fld_(b, (int)((mp >> 5) * 33u + (mp & 31u))); const cf z = a[r];
                  ka[2 * u] = 0.5f * (z.x + m.x) + hba; ka[2 * u + 1] = 0.5f * (z.y - m.y); kb[2 * u] = 0.5f * (z.y + m.y) + hbb; kb[2 * u + 1] = 0.5f * (m.x - z.x); }
              Ka[g * 512 + t3] = (h16x4){(_Float16)ka[0], (_Float16)ka[1], (_Float16)ka[2], (_Float16)ka[3]};
              Kb[g * 512 + t3] = (h16x4){(_Float16)kb[0], (_Float16)kb[1], (_Float16)kb[2], (_Float16)kb[3]}; } }
        __syncthreads();
    }
}
__device__ __forceinline__ float sc3(const bf16_t* row, int n, int lane, float w0, float w1, float w2, float bb) {
    const float x0 = bf2f(row[n]); const int nh = (lane == 0) ? max(n - 1, 0) : min(n + 1, S - 1); const float xh = bf2f(row[nh]);
    const float su = lane_prev(x0), sd = lane_next(x0);
    const float xm = (lane == 0) ? (n > 0 ? xh : 0.f) : su, xp = (lane == 0) ? sd : (n < S - 1 ? xh : 0.f);
    return xm * w0 + x0 * w1 + xp * w2 + bb;
}
__device__ __forceinline__ void hyena_fft_phase(const Ctx& c0, int l) { PH_ENTER();
    fft_tables(c);
    const bf16_t* P1 = (const bf16_t*)(c.ws + WS_P1); bf16_t* YT = (bf16_t*)(c.ws + WS_YHYT); const h16x4* KF = (const h16x4*)(c.ws + WS_KF);
    const float* cw = p->in[I_CW] + l * 3 * 1536; const float* cb = p->in[I_CB] + l * 1536;
    const int per = (1024 + c.G - 1) / c.G;
#ifdef HY_REP
    int hyrep = HY_REP; asm volatile("" : "+s"(hyrep));
#else
    const int hyrep = 1;
#endif
    Sc3Raw Rv;
#define HY_LOADV(itx) do { const int chx_ = (itx) >> 1, prx_ = (itx) & 1; const bf16_t* rvx_ = P1 + (size_t)(1024 + chx_) * T + (size_t)(2 * prx_) * S; const int tx_ = fresh(c.tid); \
        sc3_load_row(rvx_, tx_, Rv.own[0], Rv.nb[0]); sc3_load_row(rvx_ + S, tx_, Rv.own[1], Rv.nb[1]); } while (0)
    if (c.vcu * per < 1024) HY_LOADV(c.vcu * per);
    for (int kk = 0; kk < per * hyrep; ++kk) { const int k = kk % per; const int it = c.vcu * per + k; if (it >= 1024) break;
        const int ch = it >> 1, pr = it & 1; const size_t ba = (size_t)(2 * pr) * S, bb = ba + S;
        const bf16_t* rx1 = P1 + (size_t)ch * T; const bf16_t* rx2 = P1 + (size_t)(512 + ch) * T; const bf16_t* rv = P1 + (size_t)(1024 + ch) * T;
        const float wv0 = cw[1024 + ch], wv1 = cw[1536 + 1024 + ch], wv2 = cw[3072 + 1024 + ch], bv = cb[1024 + ch];
        const float wa0 = cw[ch], wa1 = cw[1536 + ch], wa2 = cw[3072 + ch], bxa = cb[ch];
        const float wb0 = cw[512 + ch], wb1 = cw[1536 + 512 + ch], wb2 = cw[3072 + 512 + ch], bxb = cb[512 + ch];
        cf z[16]; Sc3Raw R; const int ta = fresh(c.tid);
#pragma unroll
        for (int j = 0; j < 16; ++j) { const int n = ta + 512 * j; z[j] = sc3_eval2(Rv.own[0][j], Rv.nb[0][j], Rv.own[1][j], Rv.nb[1][j], j, n, wv0, wv1, wv2, bv); }
        asm volatile("" ::: "memory"); fft_conv<true>(z, KF + (size_t)((l * 2 + 0) * 512 + ch) * 8192, c, &R, rx1 + ba, rx1 + bb); asm volatile("" ::: "memory");
        const int tb = fresh(c.tid);
#pragma unroll
        for (int j = 0; j < 16; ++j) { const int n = tb + 512 * j; z[j] = sc3_eval2(R.own[0][j], R.nb[0][j], R.own[1][j], R.nb[1][j], j, n, wa0, wa1, wa2, bxa) * z[j]; }
        asm volatile("" ::: "memory"); fft_conv<true>(z, KF + (size_t)((l * 2 + 1) * 512 + ch) * 8192, c, &R, rx2 + ba, rx2 + bb); asm volatile("" ::: "memory");
        { const int kn_ = (kk + 1) % per, itn_ = c.vcu * per + kn_; HY_LOADV(itn_ < 1024 ? itn_ : it); }
        const int tc = fresh(c.tid);
#pragma unroll
        for (int j = 0; j < 16; ++j) { const int n = tc + 512 * j;
            const cf o2 = sc3_eval2(R.own[0][j], R.nb[0][j], R.own[1][j], R.nb[1][j], j, n, wb0, wb1, wb2, bxb) * z[j]; const float oa = o2.x, ob = o2.y;
            YT[(size_t)ch * T + ba + n] = (bf16_t)f2bf(oa); YT[(size_t)ch * T + bb + n] = (bf16_t)f2bf(ob); }
    }
}
constexpr int RT_S64 = 144, RT_S128 = 272;
__device__ __forceinline__ void load_tile(LAS unsigned char* dst, int stride, const bf16_t* g, size_t ld, int rows, int cpr  , int tid) {
    for (int idx = tid; idx < rows * cpr; idx += NT) { const int r = idx / cpr, cc = idx % cpr; *(LAS u32x4*)(dst + r * stride + cc * 16) = *(const u32x4*)(g + (size_t)r * ld + cc * 8); }
}
__device__ __forceinline__ bf16x8 ld_frag(const LAS unsigned char* tile, int stride, int row, int kel) { return *(const LAS bf16x8*)(tile + row * stride + kel * 2); }
#define RT_MFMA(x, y, acc) __builtin_amdgcn_mfma_f32_16x16x32_bf16((x), (y), (acc), 0, 0, 0)
__device__ __forceinline__ float ret_lgf(int h) { return log2f(1.0f - exp2f(-(5.0f + (float)h))); }
__device__ __forceinline__ float ret_lgb(int h) { return log2f(1.0f - exp2f(-(5.5f + (float)h))); }

struct RaRegs { u32x4 v[4], k[2]; };
__device__ __forceinline__ void ra_fetch(RaRegs& R, const bf16_t* P1, const bf16_t* P2, int it, int tid) {
    tid = fresh(tid);
    const int b = it >> 8, h = (it >> 6) & 3, n = it & 63; const size_t t0 = (size_t)b * S + n * 128;
#pragma unroll
    for (int u = 0; u < 4; ++u) { const int idx = tid + NT * u, r16 = idx >> 4, c16 = idx & 15; R.v[u] = *(const u32x4*)(P1 + (size_t)(1536 + h * 128 + r16) * T + t0 + c16 * 8); }
#pragma unroll
    for (int u = 0; u < 2; ++u) { const int idx = tid + NT * u, j = idx >> 3, dc = idx & 7; R.k[u] = *(const u32x4*)(P2 + (t0 + j) * P2C + 256 + h * 64 + dc * 8); }
}
__device__ __forceinline__ void ret_sums_phase(const Ctx& c0, int l) { PH_ENTER(); (void)p; (void)l;
    LAS unsigned char* VT = c.lds; LAS unsigned char* KfT = c.lds + 34816; LAS unsigned char* KbT = c.lds + 52224;
    const bf16_t* P1 = (const bf16_t*)(c.ws + WS_P1); const bf16_t* P2 = (const bf16_t*)(c.ws + WS_P2); bf16_t* KVS = (bf16_t*)(c.ws + WS_KVS);
    const int fr = c.lane & 15, fq = c.lane >> 4;
    RaRegs R;
    if (c.vcu < NB * 4 * 64) ra_fetch(R, P1, P2, c.vcu, c.tid);
    for (int it = c.vcu; it < NB * 4 * 64; it += c.G) { const int h = (it >> 6) & 3;
        const float lgf = ret_lgf(h), lgb = ret_lgb(h);
        __syncthreads();
        { const int tw_ = fresh(c.tid);
#pragma unroll
          for (int u = 0; u < 4; ++u) { const int idx = tw_ + NT * u, r16 = idx >> 4, c16 = idx & 15; *(LAS u32x4*)(VT + r16 * RT_S128 + c16 * 16) = R.v[u]; }
#pragma unroll
          for (int u2 = 0; u2 < 2; ++u2) { const int idx = tw_ + NT * u2, j = idx >> 3, dc = idx & 7; const u32x4 kv = R.k[u2];
            const float wf = __builtin_amdgcn_exp2f((float)(127 - j) * lgf), wb = __builtin_amdgcn_exp2f((float)j * lgb); const unsigned kw[4] = {kv.x, kv.y, kv.z, kv.w};
#pragma unroll
            for (int u = 0; u < 8; ++u) { const float kvl = (u & 1) ? bf_hi(kw[u >> 1]) : bf_lo(kw[u >> 1]);
                *(LAS bf16_t*)(KfT + (dc * 8 + u) * RT_S128 + j * 2) = (bf16_t)f2bf(kvl * wf); *(LAS bf16_t*)(KbT + (dc * 8 + u) * RT_S128 + j * 2) = (bf16_t)f2bf(kvl * wb); } } }
        if (it + c.G < NB * 4 * 64) ra_fetch(R, P1, P2, it + c.G, c.tid);
        __syncthreads();
        bf16x8 vf[4];
#pragma unroll
        for (int ks = 0; ks < 4; ++ks) vf[ks] = ld_frag(VT, RT_S128, 16 * c.wave + fr, 32 * ks + 8 * fq);
#pragma unroll
        for (int dir = 0; dir < 2; ++dir) { const LAS unsigned char* KT = dir ? KbT : KfT;
#pragma unroll
            for (int db = 0; db < 4; ++db) { f32x4 acc = {0.f, 0.f, 0.f, 0.f};
#pragma unroll
                for (int ks = 0; ks < 4; ++ks) acc = RT_MFMA(ld_frag(KT, RT_S128, 16 * db + fr, 32 * ks + 8 * fq), vf[ks], acc);
                u32x2 w; w.x = pg8::cvt_pk_bf16(acc[0], acc[1]); w.y = pg8::cvt_pk_bf16(acc[2], acc[3]);
                *(u32x2*)(KVS + ((size_t)it * 2 + dir) * 8192 + (16 * c.wave + fr) * 64 + 16 * db + 4 * fq) = w; } }
    }
}
__device__ __forceinline__ void ret_scan_phase(const Ctx& c0, int l) { PH_ENTER(); (void)p; (void)l;
    const bf16_t* KVS = (const bf16_t*)(c.ws + WS_KVS); bf16_t* PT = (bf16_t*)(c.ws + WS_KVP);
    for (int idx = c.vcu * NT + c.tid; idx < 16 * 2 * 4096; idx += c.G * NT) { const int e = (idx & 4095) * 2, dir = (idx >> 12) & 1, bh = idx >> 13, h = bh & 3;
        const float cd = exp2f(128.0f * (dir ? ret_lgb(h) : ret_lgf(h))); float s0 = 0.f, s1 = 0.f;
        unsigned kv[64];
#pragma unroll
        for (int u = 0; u < 64; ++u) { const int n = dir ? 63 - u : u; kv[u] = *(const unsigned*)(KVS + ((size_t)(bh * 64 + n) * 2 + dir) * 8192 + e); }
#pragma unroll
        for (int u = 0; u < 64; ++u) { const int n = dir ? 63 - u : u; *(unsigned*)(PT + ((size_t)(bh * 64 + n) * 2 + dir) * 8192 + e) = pk2(s0, s1); s0 = s0 * cd + bf_lo(kv[u]); s1 = s1 * cd + bf_hi(kv[u]); }
    }
}
struct RcRegs { u32x4 q[2], k[2], v[4], pf[2], pb[2]; };
__device__ __forceinline__ void rc_fetch(RcRegs& R, const bf16_t* P1, const bf16_t* P2, const bf16_t* PT, int it, int tid) {
    tid = fresh(tid);
    const int b = it >> 8, h = (it >> 6) & 3, n = it & 63; const size_t t0 = (size_t)b * S + n * 128;
#pragma unroll
    for (int u = 0; u < 2; ++u) { const int idx = tid + NT * u, r8 = idx >> 3, c8 = idx & 7;
        R.q[u] = *(const u32x4*)(P2 + (t0 + r8) * P2C + h * 64 + c8 * 8); R.k[u] = *(const u32x4*)(P2 + (t0 + r8) * P2C + 256 + h * 64 + c8 * 8);
        R.pf[u] = *(const u32x4*)(PT + ((size_t)it * 2 + 0) * 8192 + r8 * 64 + c8 * 8); R.pb[u] = *(const u32x4*)(PT + ((size_t)it * 2 + 1) * 8192 + r8 * 64 + c8 * 8); }
#pragma unroll
    for (int u = 0; u < 4; ++u) { const int idx = tid + NT * u, r16 = idx >> 4, c16 = idx & 15; R.v[u] = *(const u32x4*)(P1 + (size_t)(1536 + h * 128 + r16) * T + t0 + c16 * 8); }
}
__device__ __forceinline__ void ret_out_phase(const Ctx& c0, int l) { PH_ENTER(); (void)p; (void)l;
    LAS unsigned char* Kt = c.lds; LAS unsigned char* Qt = c.lds + 18432; LAS unsigned char* VT = c.lds + 36864; LAS unsigned char* Pm = c.lds + 71680; LAS unsigned char* PfT = c.lds + 106496; LAS unsigned char* PbT = c.lds + 124928;
    const bf16_t* P1 = (const bf16_t*)(c.ws + WS_P1); const bf16_t* P2 = (const bf16_t*)(c.ws + WS_P2); const bf16_t* PT = (const bf16_t*)(c.ws + WS_KVP); bf16_t* YR = (bf16_t*)(c.ws + WS_YRET);
    const int fr = c.lane & 15, fq = c.lane >> 4, i0 = 16 * c.wave, i = i0 + fr;
    RcRegs R;
    if (c.vcu < NB * 4 * 64) rc_fetch(R, P1, P2, PT, c.vcu, c.tid);
    for (int it = c.vcu; it < NB * 4 * 64; it += c.G) { const int b = it >> 8, h = (it >> 6) & 3, n = it & 63; const size_t t0 = (size_t)b * S + n * 128;
        const float lgf = ret_lgf(h), lgb = ret_lgb(h);
        __syncthreads();
        const int tw_ = fresh(c.tid);
#pragma unroll
        for (int u = 0; u < 2; ++u) { const int idx = tw_ + NT * u, r8 = idx >> 3, c8 = idx & 7;
            *(LAS u32x4*)(Qt + r8 * RT_S64 + c8 * 16) = R.q[u]; *(LAS u32x4*)(Kt + r8 * RT_S64 + c8 * 16) = R.k[u]; *(LAS u32x4*)(PfT + r8 * RT_S64 + c8 * 16) = R.pf[u]; *(LAS u32x4*)(PbT + r8 * RT_S64 + c8 * 16) = R.pb[u]; }
#pragma unroll
        for (int u = 0; u < 4; ++u) { const int idx = tw_ + NT * u, r16 = idx >> 4, c16 = idx & 15; *(LAS u32x4*)(VT + r16 * RT_S128 + c16 * 16) = R.v[u]; }
        const size_t t = t0 + i;
        u32x2 gw[8];
#pragma unroll
        for (int vb = 0; vb < 8; ++vb) gw[vb] = *(const u32x2*)(P2 + t * P2C + 512 + h * 128 + 16 * vb + 4 * fq);
        if (it + c.G < NB * 4 * 64) rc_fetch(R, P1, P2, PT, it + c.G, c.tid);
        __syncthreads();
        bf16x8 qf[2];
#pragma unroll
        for (int ks = 0; ks < 2; ++ks) qf[ks] = ld_frag(Qt, RT_S64, i, 32 * ks + 8 * fq);
#pragma unroll
        for (int jb = 0; jb < 8; ++jb) { f32x4 s = {0.f, 0.f, 0.f, 0.f};
#pragma unroll
            for (int ks = 0; ks < 2; ++ks) s = RT_MFMA(ld_frag(Kt, RT_S64, 16 * jb + fr, 32 * ks + 8 * fq), qf[ks], s);
            float pv[4];
#pragma unroll
            for (int r = 0; r < 4; ++r) { const int dl = i - (16 * jb + 4 * fq + r); pv[r] = s[r] * __builtin_amdgcn_exp2f(dl >= 0 ? (float)dl * lgf : (float)(-dl) * lgb); }
            u32x2 w; w.x = pk2(pv[0], pv[1]); w.y = pk2(pv[2], pv[3]);
            *(LAS u32x2*)(Pm + i * RT_S128 + (16 * jb + 4 * fq) * 2) = w; }
        asm volatile("s_waitcnt lgkmcnt(0)" ::: "memory");
        bf16x8 pf[4];
#pragma unroll
        for (int ks = 0; ks < 4; ++ks) pf[ks] = ld_frag(Pm, RT_S128, i, 32 * ks + 8 * fq);
        const float sf = __builtin_amdgcn_exp2f((float)(i + 1) * lgf), sb = __builtin_amdgcn_exp2f((float)(128 - i) * lgb);
        f32x4 o[8]; float ss = 0.f;
#pragma unroll
        for (int vb = 0; vb < 8; ++vb) { f32x4 a = {0.f, 0.f, 0.f, 0.f}, cf_ = {0.f, 0.f, 0.f, 0.f}, cb_ = {0.f, 0.f, 0.f, 0.f};
#pragma unroll
            for (int ks = 0; ks < 4; ++ks) a = RT_MFMA(ld_frag(VT, RT_S128, 16 * vb + fr, 32 * ks + 8 * fq), pf[ks], a);
#pragma unroll
            for (int ks = 0; ks < 2; ++ks) { cf_ = RT_MFMA(ld_frag(PfT, RT_S64, 16 * vb + fr, 32 * ks + 8 * fq), qf[ks], cf_); cb_ = RT_MFMA(ld_frag(PbT, RT_S64, 16 * vb + fr, 32 * ks + 8 * fq), qf[ks], cb_); }
            o[vb] = a + sf * cf_ + sb * cb_; ss += (o[vb][0] * o[vb][0] + o[vb][1] * o[vb][1]) + (o[vb][2] * o[vb][2] + o[vb][3] * o[vb][3]); }
        ss += swz_xor<16>(ss); ss += xor32(ss, c.lane);
        const float rn = __builtin_amdgcn_rsqf(ss * (1.0f / 128.0f) + EPS);
#pragma unroll
        for (int vb = 0; vb < 8; ++vb) { const int col = h * 128 + 16 * vb + 4 * fq;
            const float g0 = bf_lo(gw[vb].x), g1 = bf_hi(gw[vb].x), g2 = bf_lo(gw[vb].y), g3 = bf_hi(gw[vb].y);
            u32x2 w; w.x = pk2(o[vb][0] * rn * (g0 * sigmoidf_(g0)), o[vb][1] * rn * (g1 * sigmoidf_(g1))); w.y = pk2(o[vb][2] * rn * (g2 * sigmoidf_(g2)), o[vb][3] * rn * (g3 * sigmoidf_(g3)));
            *(u32x2*)(YR + t * 512 + col) = w; }
    }
}
constexpr int FG_H3 = 82432, FG_W4T = 100864, FG_S = 144;
__device__ __forceinline__ void filters_phase(const Ctx& c0) { PH_ENTER();
    LAS float* feat = (LAS float*)c.lds;
    LAS float* hA = (LAS float*)(c.lds + 16896);
    LAS float* hB = (LAS float*)(c.lds + 49664);
    LAS unsigned char* H3 = c.lds + FG_H3;
    LAS unsigned char* W4T = c.lds + FG_W4T;
    _Float16* kt = (_Float16*)(c.ws + WS_KT); float* l1p = (float*)(c.ws + WS_L1P);
    const float min_decay = logf(1e-2f) / 1.5f, max_decay = logf(1e-2f) / 0.3f;
    const int fr = c.lane & 15, fq = c.lane >> 4;
    for (int it = c.vcu; it < DEPTH * 64; it += c.G) { const int l = it >> 6, pb_ = it & 63, p0 = pb_ * 128;
        const float* w1 = p->in[I_W1] + l * 33 * 64; const float* b1 = p->in[I_B1] + l * 64; const float* w2 = p->in[I_W2] + l * 4096; const float* b2 = p->in[I_B2] + l * 64;
        const float* w3 = p->in[I_W3] + l * 4096; const float* b3 = p->in[I_B3] + l * 64; const float* w4 = p->in[I_W4] + (size_t)l * 64 * 2048; const float* frq = p->in[I_FREQ] + l * 64;
        __syncthreads();
        for (int idx = c.tid; idx < 128 * 33; idx += NT) { const int pp = idx / 33, j = idx % 33; const int pos = p0 + pp; float v;
            if (j == 0) v = (float)pos / 8191.0f;
            else { const float w = 6.283185307179586f * (float)pos / 8192.0f; const int jj = (j - 1) & 15; const float f = 1e-4f + (float)jj * ((15.0f - 1e-4f) / 15.0f);
                v = j <= 16 ? cosf(f * w) : -sinf(f * w); }
            feat[idx] = v; }
        __syncthreads();
        { const int tm = fresh(c.tid), n = tm & 63, pw0 = tm >> 6;
          { float wr_[33];
#pragma unroll
            for (int j = 0; j < 33; ++j) wr_[j] = w1[j * 64 + n];
            const float bn = b1[n], fn = frq[n];
            for (int i = 0; i < 16; ++i) { const int pp = pw0 + 8 * i; float s = bn;
#pragma unroll
                for (int j = 0; j < 33; ++j) s += feat[pp * 33 + j] * wr_[j];
                hA[pp * 64 + n] = sinf(fn * s); } }
          __syncthreads();
          { float wr_[64];
#pragma unroll
            for (int j = 0; j < 64; ++j) wr_[j] = w2[j * 64 + n];
            const float bn = b2[n], fn = frq[n];
            for (int i = 0; i < 16; ++i) { const int pp = pw0 + 8 * i; float s = bn;
#pragma unroll
                for (int q = 0; q < 16; ++q) { const f32x4 h4 = *(const LAS f32x4*)(hA + pp * 64 + 4 * q); s += (h4.x * wr_[4 * q] + h4.y * wr_[4 * q + 1]) + (h4.z * wr_[4 * q + 2] + h4.w * wr_[4 * q + 3]); }
                hB[pp * 64 + n] = sinf(fn * s); } }
          __syncthreads();
          { float wr_[64];
#pragma unroll
            for (int j = 0; j < 64; ++j) wr_[j] = w3[j * 64 + n];
            const float bn = b3[n], fn = frq[n];
            for (int i = 0; i < 16; ++i) { const int pp = pw0 + 8 * i; float s = bn;
#pragma unroll
                for (int q = 0; q < 16; ++q) { const f32x4 h4 = *(const LAS f32x4*)(hB + pp * 64 + 4 * q); s += (h4.x * wr_[4 * q] + h4.y * wr_[4 * q + 1]) + (h4.z * wr_[4 * q + 2] + h4.w * wr_[4 * q + 3]); }
                *(LAS bf16_t*)(H3 + pp * FG_S + n * 2) = (bf16_t)f2bf(sinf(fn * s)); } } }
        for (int ch8 = 0; ch8 < 8; ++ch8) {
            __syncthreads();
            for (int idx = c.tid; idx < 64 * 256; idx += NT) { const int k = idx >> 8, cc = idx & 255; *(LAS bf16_t*)(W4T + cc * FG_S + k * 2) = (bf16_t)f2bf(w4[(size_t)k * 2048 + ch8 * 256 + cc]); }
            __syncthreads();
            bf16x8 y[2][2];
#pragma unroll
            for (int cb = 0; cb < 2; ++cb)
#pragma unroll
                for (int ks = 0; ks < 2; ++ks) y[cb][ks] = *(const LAS bf16x8*)(W4T + (16 * (2 * c.wave + cb) + fr) * FG_S + (32 * ks + 8 * fq) * 2);
            float l1s[2] = {0.f, 0.f};
#pragma unroll
            for (int pb = 0; pb < 8; ++pb) { bf16x8 x[2];
#pragma unroll
                for (int ks = 0; ks < 2; ++ks) x[ks] = *(const LAS bf16x8*)(H3 + (16 * pb + fr) * FG_S + (32 * ks + 8 * fq) * 2);
#pragma unroll
                for (int cb = 0; cb < 2; ++cb) { f32x4 a = {0.f, 0.f, 0.f, 0.f};
                    a = __builtin_amdgcn_mfma_f32_16x16x32_bf16(x[0], y[cb][0], a, 0, 0, 0); a = __builtin_amdgcn_mfma_f32_16x16x32_bf16(x[1], y[cb][1], a, 0, 0, 0);
                    const int col = ch8 * 256 + 16 * (2 * c.wave + cb) + fr, dir = col >> 10, o = (col >> 9) & 1, ch = col & 511, pos = p0 + 16 * pb + 4 * fq;
                    const float delta = fabsf(min_decay + (float)ch * ((max_decay - min_decay) / 511.0f));
                    const float rho = expf(-delta * (1.0f / 8191.0f)); float e = expf(-delta * ((float)pos / 8191.0f)); f32x4 v;
#pragma unroll
                    for (int r = 0; r < 4; ++r) { v[r] = a[r] * e; e *= rho; }
                    _Float16* kr = kt + ((size_t)(l * 2 + o) * 512 + ch) * 16384;
                    typedef _Float16 h16x4f __attribute__((ext_vector_type(4)));
                    if (dir == 0) *(h16x4f*)(kr + pos) = (h16x4f){(_Float16)v[0], (_Float16)v[1], (_Float16)v[2], (_Float16)v[3]};
                    else {
#pragma unroll
                        for (int r = 0; r < 4; ++r) { if (pos + r == 0) { v[r] = 0.f; kr[8192] = (_Float16)0.f; } else kr[16384 - pos - r] = (_Float16)v[r]; } }
                    l1s[cb] += (fabsf(v[0]) + fabsf(v[1])) + (fabsf(v[2]) + fabsf(v[3])); } }
#pragma unroll
            for (int cb = 0; cb < 2; ++cb) { float a = l1s[cb]; a += swz_xor<16>(a); a += xor32(a, c.lane);
                if (fq == 0) l1p[((size_t)l * 64 + pb_) * 2048 + ch8 * 256 + 16 * (2 * c.wave + cb) + fr] = a; }
        }
    }
}
__device__ __forceinline__ void stagger_start(const Ctx& c0, int mul) { int n_ = (int)((c0.bid >> 4) & 3) * mul; asm volatile("" : "+s"(n_)); for (int i_ = 0; i_ < n_; ++i_) __builtin_amdgcn_s_sleep(127); }
#if !defined(ROT) && !defined(ROT2) && !defined(NO_DESYNC)
#define ROT2 1
#define STAGGER 1
#define STAGGER_G 3
#endif
#ifndef STAGGER_U
#define STAGGER_U 127
#endif
#ifndef STG_GU
#define STG_GU 0
#endif
#ifndef STG_DN
#define STG_DN 0
#endif
#ifndef STG_MG
#define STG_MG 0
#endif
#ifndef STG_OUT
#define STG_OUT 0
#endif
__device__ __forceinline__ void inproj_part(const Ctx& c0, int l, int part) { PH_ENTER(); (void)p;
    const bf16_t* H8 = (const bf16_t*)(c.ws + WS_H8A);
    if (part == 0) {
        pg8::Gemm g{(const bf16_t*)(c.ws + WS_WIN1 + (size_t)l * P1R * D), H8, D / 2, D / 2, D / 2, 0};
        pg8::StaticOrder S_; S_.init(P1R, T, c.G, c.bid);
        pg8::EpiPlain E{(bf16_t*)(c.ws + WS_P1), T, 0.03125f};
        pg8::gemm_phase<pg8::EpiPlain, pg8::StaticOrder, false, true>(c.lds, g, S_, E, nullptr, c.tid);
    } else {
        pg8::Gemm g{H8, (const bf16_t*)(c.ws + WS_WIN2 + (size_t)l * P2C * D), D / 2, D / 2, D / 2, 0};
        pg8::StaticOrder S_; S_.init(T, P2C, c.G, c.bid);
        pg8::EpiP2 E{(bf16_t*)(c.ws + WS_P2), (const float*)(c.ws + WS_ROPE), 0.03125f};
        pg8::gemm_phase<pg8::EpiP2, pg8::StaticOrder, false, true>(c.lds, g, S_, E, nullptr, c.tid);
    }
}
__device__ __forceinline__ void inproj_phase(const Ctx& c0, int l) {
#ifdef STAGGER
    { int n_ = (int)((c0.bid >> 4) & STAGGER_G) * STAGGER; asm volatile("" : "+s"(n_)); for (int i_ = 0; i_ < n_; ++i_) __builtin_amdgcn_s_sleep(STAGGER_U); }
#endif
#ifdef ROT2
    { int odd_ = (c0.bid >> 3) & 1; asm volatile("" : "+s"(odd_)); if (odd_) inproj_part(c0, l, 1); }
    inproj_part(c0, l, 0);
    { int odd_ = (c0.bid >> 3) & 1; asm volatile("" : "+s"(odd_)); if (!odd_) inproj_part(c0, l, 1); }
#else
    inproj_part(c0, l, 0); inproj_part(c0, l, 1);
#endif
}
__device__ __forceinline__ void merge_phase(const Ctx& c0, int l) { if (STG_MG) stagger_start(c0, STG_MG); PH_ENTER(); (void)p;
    pg8::Gemm g{(const bf16_t*)(c.ws + WS_YHY), (const bf16_t*)(c.ws + WS_WHY) + (size_t)l * D * 512, 512, 512, 512, (WS_WRET - WS_WHY) / 2, (WS_YRET - WS_YHY) / 2};
    pg8::PairOrder S_; S_.init(T, D, c.G, c.bid);
    pg8::EpiMerge E{(bf16_t*)(c.ws + WS_MRG)};
    pg8::gemm_phase<pg8::EpiMerge, pg8::PairOrder, false>(c.lds, g, S_, E, nullptr, c.tid);
}
__device__ __forceinline__ void outproj_phase(const Ctx& c0, int l, const int dry = 0) { if (STG_OUT) stagger_start(c0, STG_OUT); PH_ENTER();
    pg8::Gemm g{(const bf16_t*)(c.ws + WS_MRG), (const bf16_t*)(c.ws + WS_WOUT) + (size_t)l * D * D, D, D, D, 0};
    pg8::StaticOrder S_; S_.init(T, D, c.G, c.bid);
    pg8::EpiOut E{(bf16_t*)(c.ws + (dry ? WS_KT : WS_X)), l == 0 ? p->in[I_X] : (const float*)nullptr, (const bf16_t*)(c.ws + WS_X), (const float*)(c.ws + WS_MOD) + (size_t)l * NB * 6144 + 2 * 1024};
    pg8::gemm_phase<pg8::EpiOut, pg8::StaticOrder, false>(c.lds, g, S_, E, nullptr, c.tid);
}
__device__ __forceinline__ int moe_tables(const Ctx& c, int l) {
    LAS int* tab = (LAS int*)(c.lds + LDS_TAB); LAS int* tile_e = tab + 128;
    expert_tile_prefix((const unsigned*)(c.ws + WS_CTL) + CW_CNT + l * 32, tab, c.tid);
    __syncthreads();
    const int nMt = tab[64];
    for (int pm = c.tid; pm < nMt; pm += NT) { int e = 0;
#pragma unroll 1
        for (int q = 1; q < 32; ++q) if (tab[q] <= pm * 256) e = q;
        while (e > 0 && ((tab[32 + e] + 255) >> 8) == 0) --e;
        tile_e[pm] = e; }
    __syncthreads();
    return nMt;
}
__device__ __forceinline__ void moe_gu_phase(const Ctx& c0, int l) { if (STG_GU) stagger_start(c0, STG_GU); PH_ENTER();
    LAS int* tab = (LAS int*)(c.lds + LDS_TAB); LAS int* tile_e = tab + 128; LAS int* rowtab = tab + 1024;
    const int nMt = moe_tables(c, l);
    pg8::MoeOrder S_; S_.init(nMt, 2048 / 256, c.G, c.bid, tile_e);
    const int* slot_tok = (const int*)(c.ws + WS_SLOT);
    { pg8::Unit u; for (int ui = 0; S_.next(ui, u); ++ui) { if (c.tid < 256) { const int e = u.e, local = u.pm * 256 - tab[e] + c.tid; rowtab[ui * 256 + c.tid] = local < tab[32 + e] ? slot_tok[e * CAP + local] : 0; } } }
    __syncthreads();
    pg8::Gemm g{(const bf16_t*)(c.ws + WS_H), (const bf16_t*)(c.ws + WS_WGU + (size_t)l * NE * 2048 * D), D / 2, D / 2, D / 2, (size_t)2048 * D / 2};
    pg8::EpiGU8 E{l};
    pg8::gemm_phase<pg8::EpiGU8, pg8::MoeOrder, true, true>(c.lds, g, S_, E, rowtab, c.tid);
}
__device__ __forceinline__ void moe_down_phase(const Ctx& c0, int l) { if (STG_DN) stagger_start(c0, STG_DN); PH_ENTER();
    LAS int* tab = (LAS int*)(c.lds + LDS_TAB); LAS int* tile_e = tab + 128;
    const int nMt = moe_tables(c, l);
    pg8::MoeOrder S_; S_.init(nMt, D / 256, c.G, c.bid, tile_e);
    pg8::Gemm g{(const bf16_t*)(c.ws + WS_ACT), (const bf16_t*)(c.ws + WS_WDN + (size_t)l * NE * D * FF), FF / 2, FF / 2, FF / 2, (size_t)D * FF / 2};
    pg8::EpiDown E{l, 0.03125f};
    pg8::gemm_phase<pg8::EpiDown, pg8::MoeOrder, false, true>(c.lds, g, S_, E, nullptr, c.tid);
}

__device__ __forceinline__ Ctx make_ctx(const Params& p, unsigned char* lds_generic) {
    Ctx c; c.lds = (LAS unsigned char*)lds_generic; c.tid = threadIdx.x; c.lane = c.tid & 63; c.wave = __builtin_amdgcn_readfirstlane(c.tid >> 6);
    c.bid = blockIdx.x; c.G = gridDim.x; c.vcu = (c.G % 8 == 0) ? (c.bid % 8) * (c.G / 8) + c.bid / 8 : c.bid; c.ws = p.ws; return c;
}
__global__ void __launch_bounds__(NT, 2) k_mega(Params p) {
    extern __shared__ __attribute__((aligned(16))) unsigned char lds_raw[];
    const Ctx c = make_ctx(p, lds_raw);
    volatile LAS unsigned* st = (volatile LAS unsigned*)(c.lds + LDS_BYTES - 16);
    if (c.tid == 0) { st[0] = 0u; st[1] = 0u; st[2] = 0u; st[3] = 0u; }
    __syncthreads();
    (void)xcd_barrier_post((unsigned*)(get_kp()->ws + WS_CTL) + CW_BAR, st);
#define GRID_BAR() do { XcdBarrier b_; b_.bar = (unsigned*)(get_kp()->ws + WS_CTL) + CW_BAR; b_.x = xb_xcc_id(); b_.st = (volatile LAS unsigned*)(c.lds + LDS_BYTES - 16); int w_ = c.wave; asm volatile("" : "+s"(w_)); \
    unsigned m_ = ~0u; asm volatile("" : "+s"(m_)); xcd_barrier(b_, w_ == 0 && __builtin_amdgcn_mbcnt_hi(m_, __builtin_amdgcn_mbcnt_lo(m_, 0u)) == 0u); } while (0)
#ifndef REP_MASK
#define REP_MASK 0
#endif
#define REPD(bit, call) do { if ((REP_MASK >> (bit)) & 1) { int nrep_ = 2; asm volatile("" : "+s"(nrep_)); for (int r_ = 0; r_ < nrep_; ++r_) { if (r_) GRID_BAR(); const int dry_ = (r_ == 0); call; } } else { const int dry_ = 0; call; } } while (0)
#define REP(bit, stmt) do { if ((REP_MASK >> (bit)) & 1) { int nrep_ = 2; asm volatile("" : "+s"(nrep_)); for (int r_ = 0; r_ < nrep_; ++r_) { if (r_) GRID_BAR(); stmt; } } else { stmt; } } while (0)
    REP(0, prologue_phase(c)); REP(11, filters_phase(c));
    GRID_BAR();
    REP(1, kspec_phase(c));
    for (int l = 0; l < DEPTH; ++l) {
        if (l == 0) REP(12, norm_phase<0>(c, l)); else REPD(12, norm_phase<1>(c, l, dry_));
        GRID_BAR();
        REP(2, inproj_phase(c, l));
        GRID_BAR();
        REP(3, hyena_fft_phase(c, l)); __syncthreads(); REP(4, ret_sums_phase(c, l));
        GRID_BAR();
        REP(5, transpose_yhy_phase(c)); REP(10, ret_scan_phase(c, l));
        GRID_BAR();
        REP(6, ret_out_phase(c, l));
        GRID_BAR();
        REP(7, merge_phase(c, l));
        GRID_BAR();
        REPD(13, outproj_phase(c, l, dry_));
        GRID_BAR();
        REPD(14, normf_phase(c, l, dry_));
        GRID_BAR();
        REP(8, moe_gu_phase(c, l));
        GRID_BAR();
        REP(9, moe_down_phase(c, l));
        GRID_BAR();
    }
    norm_phase<3>(c, 0);
}

extern "C" void kernel_launch(void* const* d_in, const int* in_sizes, int n_in, void* d_out, int out_size, void* d_ws, size_t ws_size, hipStream_t stream) {
    static int grid = 0;
    if (grid == 0) {
        if (n_in != N_IN || in_sizes[0] != T * D || out_size != T * D || ws_size < WS_END) { fprintf(stderr, "kernel_launch: unexpected shapes (n_in %d, in0 %d, out %d, ws %zu < %zu)\n", n_in, n_in > 0 ? in_sizes[0] : -1, out_size, ws_size, (size_t)WS_END); grid = -1; return; }
        int dev = 0, cus = 0, per_cu = 0;
        if (hipGetDevice(&dev) != hipSuccess || hipDeviceGetAttribute(&cus, hipDeviceAttributeMultiprocessorCount, dev) != hipSuccess) { grid = -1; return; }
        if (hipFuncSetAttribute((const void*)k_mega, hipFuncAttributeMaxDynamicSharedMemorySize, LDS_BYTES) != hipSuccess) { fprintf(stderr, "kernel_launch: hipFuncSetAttribute failed\n"); grid = -1; return; }
        if (hipOccupancyMaxActiveBlocksPerMultiprocessor(&per_cu, (const void*)k_mega, NT, LDS_BYTES) != hipSuccess || per_cu < 1) fprintf(stderr, "kernel_launch: note: occupancy query reports %d workgroups per CU\n", per_cu);
        (void)hipGetLastError();
        grid = cus;
    }
    if (grid < 0) return;
    (void)hipMemsetAsync((char*)d_ws + WS_CTL, 0, CTL_BYTES, stream);
    Params p{};
    for (int i = 0; i < N_IN; ++i) p.in[i] = (const float*)d_in[i];
    p.out = (float*)d_out; p.ws = (unsigned char*)d_ws; p.phase = 0; p.layer = 0;
    hipLaunchKernelGGL(k_mega, dim3(grid), dim3(NT), LDS_BYTES, stream, p);
    const hipError_t e = hipPeekAtLastError(); if (e != hipSuccess) fprintf(stderr, "kernel_launch: launch failed: %s\n", hipGetErrorName(e));
}
```
